# Optimizing an MI355X kernel written in HIP

```python
import jax, jax.numpy as jnp
from jax import lax
import numpy as np

D_MODEL = 1024
BATCH = 8
SEQ = 2048
DEPTH = 4

N_META = 16
D_FF = 2816
RES_HALF = 0.5
EPS = 1e-6
SB_HEADS = 16
SB_HEAD_DIM = D_MODEL // SB_HEADS
SB_BLOCK = 128
GLA_HEADS = 4
GLA_DK = D_MODEL // 2
GLA_DV = D_MODEL
GLA_HK = GLA_DK // GLA_HEADS
GLA_HV = GLA_DV // GLA_HEADS
GLA_GATE_RANK = 16
GLA_TAU = 16.0
GLA_CHUNK = 64
GLA_IN = 2 * GLA_DK + 2 * GLA_DV + GLA_GATE_RANK
N_SB = (DEPTH + 1) // 2
N_GLA = DEPTH // 2

kernel_name = "hybrid_stickbreak_gla_macaron"


def _rmsnorm(x, g):
    xf = x.astype(jnp.float32)
    y = xf * lax.rsqrt(jnp.mean(xf * xf, axis=-1, keepdims=True) + EPS)
    return (y * g.astype(jnp.float32)).astype(x.dtype)


def _swiglu(h, w_gu, w_down):
    g, u = jnp.split(h @ w_gu, 2, axis=-1)
    return (jax.nn.silu(g) * u) @ w_down


def _stick_breaking(h, w_qkv, g_q, g_k, w_o):
    B, L, _ = h.shape
    qkv = (h @ w_qkv).reshape(B, L, 3, SB_HEADS, SB_HEAD_DIM)
    q = _rmsnorm(qkv[:, :, 0], g_q)
    k = _rmsnorm(qkv[:, :, 1], g_k)
    v = qkv[:, :, 2]
    pad = (-L) % SB_BLOCK
    def prep(t):
        return jnp.pad(t, ((0, 0), (pad, 0), (0, 0), (0, 0))).transpose(0, 2, 1, 3)
    q, k, v = prep(q), prep(k), prep(v)
    Lp = L + pad
    scale = SB_HEAD_DIM ** -0.5
    outs = []
    for t0 in range(0, Lp, SB_BLOCK):
        t1 = t0 + SB_BLOCK
        z = jnp.einsum('bhtd,bhsd->bhts', q[:, :, t0:t1], k[:, :, :t1]).astype(jnp.float32) * scale
        t_pos = jnp.arange(t0, t1)[:, None]
        s_pos = jnp.arange(t1)[None, :]
        mask = (s_pos < t_pos) & (s_pos >= pad)
        log_1m = jnp.where(mask, jax.nn.log_sigmoid(-z), 0.0)
        log_after = lax.cumsum(log_1m, axis=3, reverse=True) - log_1m
        w = jnp.where(mask, jnp.exp(jax.nn.log_sigmoid(z) + log_after), 0.0)
        outs.append(jnp.einsum('bhts,bhsd->bhtd', w.astype(v.dtype), v[:, :, :t1]))
    o = jnp.concatenate(outs, axis=2)[:, :, pad:]
    o = o.transpose(0, 2, 1, 3).reshape(B, L, SB_HEADS * SB_HEAD_DIM)
    return o @ w_o


def _gla(h, w_in, w_gate_up, b_gate, g_out, w_o):
    B, L, _ = h.shape
    f32 = jnp.float32
    proj = h @ w_in
    q, k, v, r, g_low = jnp.split(
        proj, [GLA_DK, 2 * GLA_DK, 2 * GLA_DK + GLA_DV, 2 * GLA_DK + 2 * GLA_DV], axis=-1)
    log_a = jax.nn.log_sigmoid((g_low @ w_gate_up + b_gate).astype(f32)) / GLA_TAU
    pad = (-L) % GLA_CHUNK
    Lp = L + pad
    N = Lp // GLA_CHUNK
    def chunk(t, hd):
        t = jnp.pad(t, ((0, 0), (pad, 0), (0, 0)))
        return t.reshape(B, N, GLA_CHUNK, GLA_HEADS, hd).transpose(0, 3, 1, 2, 4)
    qc = chunk(q.astype(f32) * GLA_HK ** -0.5, GLA_HK)
    kc = chunk(k.astype(f32), GLA_HK)
    vc = chunk(v.astype(f32), GLA_HV)
    ac = chunk(log_a, GLA_HK)
    b = jnp.cumsum(ac, axis=3)
    b_last = b[:, :, :, -1:, :]
    q_dec = qc * jnp.exp(b)
    k_dec = kc * jnp.exp(-b)
    k_st = kc * jnp.exp(b_last - b)
    causal = jnp.tril(jnp.ones((GLA_CHUNK, GLA_CHUNK), dtype=bool))
    att = jnp.where(causal, jnp.einsum('bhnck,bhnsk->bhncs', q_dec, k_dec), 0.0)
    o_intra = jnp.einsum('bhncs,bhnsv->bhncv', att, vc)

    def step(S, xs):
        q_n, k_n, v_n, dec_n = xs
        o_n = jnp.einsum('bhck,bhkv->bhcv', q_n, S)
        S = S * jnp.swapaxes(dec_n, -1, -2) + jnp.einsum('bhck,bhcv->bhkv', k_n, v_n)
        return S, o_n

    xs = tuple(jnp.moveaxis(t, 2, 0) for t in (q_dec, k_st, vc, jnp.exp(b_last)))
    S0 = jnp.zeros((B, GLA_HEADS, GLA_HK, GLA_HV), f32)
    _, o_inter = lax.scan(step, S0, xs)
    o = o_intra + jnp.moveaxis(o_inter, 0, 2)
    o = o.transpose(0, 2, 3, 1, 4).reshape(B, Lp, GLA_HEADS, GLA_HV)[:, pad:]
    o = o * lax.rsqrt(jnp.mean(o * o, axis=-1, keepdims=True) + EPS)
    o = o * g_out.astype(f32).reshape(GLA_HEADS, GLA_HV)
    o = o.reshape(B, L, GLA_DV) * jax.nn.silu(r.astype(f32))
    return o.astype(h.dtype) @ w_o


def setup_inputs(seed: int = 0) -> dict:
    key = jax.random.key(seed)
    ks = jax.random.split(key, 20)
    f32 = jnp.float32
    def dense(k, shape, fan_in):
        return jax.random.normal(k, shape, f32) * fan_in ** -0.5
    def gain(k, shape):
        return 1.0 + 0.02 * jax.random.normal(k, shape, f32)
    return {
        "x": jax.random.normal(ks[0], (BATCH, SEQ, D_MODEL), f32),
        "meta": jax.random.normal(ks[1], (N_META, D_MODEL), f32),
        "ffn_a_norm": gain(ks[2], (DEPTH, D_MODEL)),
        "ffn_a_w_gu": dense(ks[3], (DEPTH, D_MODEL, 2 * D_FF), D_MODEL),
        "ffn_a_w_down": dense(ks[4], (DEPTH, D_FF, D_MODEL), D_FF),
        "mix_norm": gain(ks[5], (DEPTH, D_MODEL)),
        "sb_w_qkv": dense(ks[6], (N_SB, D_MODEL, 3 * D_MODEL), D_MODEL),
        "sb_q_norm": gain(ks[7], (N_SB, SB_HEAD_DIM)),
        "sb_k_norm": gain(ks[8], (N_SB, SB_HEAD_DIM)),
        "sb_w_o": dense(ks[9], (N_SB, D_MODEL, D_MODEL), D_MODEL),
        "gla_w_in": dense(ks[10], (N_GLA, D_MODEL, GLA_IN), D_MODEL),
        "gla_w_gate_up": dense(ks[11], (N_GLA, GLA_GATE_RANK, GLA_DK), GLA_GATE_RANK),
        "gla_b_gate": 0.1 * jax.random.normal(ks[12], (N_GLA, GLA_DK), f32),
        "gla_out_norm": gain(ks[13], (N_GLA, GLA_DV)),
        "gla_w_o": dense(ks[14], (N_GLA, GLA_DV, D_MODEL), GLA_DV),
        "ffn_b_norm": gain(ks[15], (DEPTH, D_MODEL)),
        "ffn_b_w_gu": dense(ks[16], (DEPTH, D_MODEL, 2 * D_FF), D_MODEL),
        "ffn_b_w_down": dense(ks[17], (DEPTH, D_FF, D_MODEL), D_FF),
    }


def reference(x, meta, ffn_a_norm, ffn_a_w_gu, ffn_a_w_down, mix_norm,
              sb_w_qkv, sb_q_norm, sb_k_norm, sb_w_o,
              gla_w_in, gla_w_gate_up, gla_b_gate, gla_out_norm, gla_w_o,
              ffn_b_norm, ffn_b_w_gu, ffn_b_w_down):
    B = x.shape[0]
    m = jnp.broadcast_to(meta.astype(x.dtype)[None], (B, N_META, x.shape[-1]))
    h = jnp.concatenate([m, x], axis=1)
    for i in range(DEPTH):
        h = h + RES_HALF * _swiglu(_rmsnorm(h, ffn_a_norm[i]), ffn_a_w_gu[i], ffn_a_w_down[i])
        hn = _rmsnorm(h, mix_norm[i])
        j = i // 2
        if i % 2 == 0:
            h = h + _stick_breaking(hn, sb_w_qkv[j], sb_q_norm[j], sb_k_norm[j], sb_w_o[j])
        else:
            h = h + _gla(hn, gla_w_in[j], gla_w_gate_up[j], gla_b_gate[j], gla_out_norm[j], gla_w_o[j])
        h = h + RES_HALF * _swiglu(_rmsnorm(h, ffn_b_norm[i]), ffn_b_w_gu[i], ffn_b_w_down[i])
    return h[:, N_META:]
```

```cpp
#include <hip/hip_runtime.h>
#include <hip/hip_cooperative_groups.h>
#include <cstdio>
#include <cstdint>

namespace pg8 {
#define PG8_LAS __attribute__((address_space(3)))
typedef unsigned short bf16_t;
typedef short bf16x8 __attribute__((ext_vector_type(8)));
typedef float f32x4 __attribute__((ext_vector_type(4)));
typedef unsigned u32x4 __attribute__((ext_vector_type(4)));
constexpr int BM = 256, BK = 64, HALF = 128, HTB = HALF * BK * 2  , STAGE_BYTES = 8 * HTB, NXCD = 8, WGM = 4;

__host__ __device__ __forceinline__ int lds_byte(int r, int c) { const int st = (r >> 4) * 2 + (c >> 5), rr = r & 15, cc = c & 31, ob = rr * 64 + cc * 2; return st * 1024 + (ob ^ (((ob >> 9) & 1) << 5)); }
__host__ __device__ __forceinline__ void stage_rc(int b, int& R, int& C) { const int st = b / 1024, sb = b % 1024, swz = sb ^ (((sb >> 9) & 1) << 5); R = (st >> 1) * 16 + swz / 64; C = (st & 1) * 32 + (swz % 64) / 2; }
__host__ __device__ __forceinline__ int perm32(int rho) { const int n = rho >> 4, i = rho & 15; return 8 * (i >> 2) + 4 * n + (i & 3); }

struct Unit { int pm, pn, kt0, nt; };
struct Gemm { const bf16_t* A; const bf16_t* Bt; int M, N, K; };

struct StaticOrder {
    int nM, nN, nwg, G, c, ntf;
    __host__ __device__ void init(int M, int N, int G_, int c_, int ntf_) { nM = M / BM; nN = N / BM; nwg = nM * nN; G = G_; c = c_; ntf = ntf_; }
    __host__ __device__ bool next(int i, Unit& u) const {
        const long L = (long)i * G + c; if (L >= nwg) return false;
        int wgid = (int)L; { const int q = nwg / NXCD, r = nwg % NXCD, xcd = wgid % NXCD, off = wgid / NXCD; wgid = (xcd < r ? xcd * (q + 1) : r * (q + 1) + (xcd - r) * q) + off; }
        const int nig = WGM * nN, gid = wgid / nig, fm = gid * WGM, gsz = (nM - fm) < WGM ? (nM - fm) : WGM;
        u.pm = fm + ((wgid % nig) % gsz); u.pn = (wgid % nig) / gsz; u.kt0 = 0; u.nt = ntf; return true;
    }
    __device__ __forceinline__ void a_ready(const Unit&) const {}
    __device__ __forceinline__ void done(const Unit&) const {}
};

__device__ __forceinline__ unsigned cvt_pk_bf16(float lo, float hi) { unsigned r; asm volatile("v_cvt_pk_bf16_f32 %0, %1, %2" : "=v"(r) : "v"(lo), "v"(hi)); return r; }
typedef float f32x2 __attribute__((ext_vector_type(2)));

struct SplitTailOrder {
    StaticOrder S0; int nsplit, c;
    __host__ __device__ void init(int G_, int c_, int ntf_, int nsplit_) { S0.init(64 * BM, 1024, G_, c_, ntf_); nsplit = nsplit_; c = c_; }
    __host__ __device__ bool next(int i, Unit& u) const {
        if (i == 0) return S0.next(0, u);
        if (i == 1 && c < 4 * nsplit) { u.pm = 64; u.pn = c & 3; u.nt = S0.ntf / nsplit; u.kt0 = (c >> 2) * u.nt; return true; }
        return false;
    }
    __device__ __forceinline__ void a_ready(const Unit&) const {}
    __device__ __forceinline__ void done(const Unit&) const {}
};
constexpr float RMS_EPS = 1e-6f;
constexpr int M_REAL = 16512, SEQ_L = 2064;
__device__ __forceinline__ float row_rs(const float* SS, int row, int fq) {
    const f32x4 a = *(const f32x4*)(SS + (size_t)row * 16 + 4 * fq);
    float s = (a[0] + a[1]) + (a[2] + a[3]);
    s += __shfl_xor(s, 16); s += __shfl_xor(s, 32);
    return __builtin_amdgcn_rsqf(s * (1.0f / 1024.0f) + RMS_EPS);
}
__device__ __forceinline__ void row_rs8(const float* SS, int row0, int fq, float (&rs)[2][4]) {
    f32x4 a[2][4];
#pragma unroll
    for (int ai = 0; ai < 2; ++ai)
#pragma unroll
        for (int m = 0; m < 4; ++m) a[ai][m] = *(const f32x4*)(SS + (size_t)(row0 + ai * HALF + m * 16) * 16 + 4 * fq);
#pragma unroll
    for (int ai = 0; ai < 2; ++ai)
#pragma unroll
        for (int m = 0; m < 4; ++m) { float s = (a[ai][m][0] + a[ai][m][1]) + (a[ai][m][2] + a[ai][m][3]); s += __shfl_xor(s, 16); s += __shfl_xor(s, 32); rs[ai][m] = __builtin_amdgcn_rsqf(s * (1.0f / 1024.0f) + RMS_EPS); }
}
__device__ __forceinline__ float silu_f(float g) { return g * __builtin_amdgcn_rcpf(1.0f + __expf(-g)); }

struct EpiGU {
    static constexpr bool PERM = true, AFTER_DRAIN = false;
    bf16_t* ACT; const float* SS;
    __device__ __forceinline__ void operator()(const f32x4 (&acc)[2][2][4][2], const Unit& u, int wr, int wc, int fr, int fq) const {
        const int row0 = u.pm * BM + wr * 64 + fr, col0 = u.pn * 128 + wc * 32 + 8 * fq;
        float rs8[2][4]; row_rs8(SS, row0, fq, rs8);
#pragma unroll
        for (int ai = 0; ai < 2; ++ai)
#pragma unroll
            for (int m = 0; m < 4; ++m) {
                const int row = row0 + ai * HALF + m * 16; const float rs = rs8[ai][m];
                float o[8];
#pragma unroll
                for (int n = 0; n < 2; ++n)
#pragma unroll
                    for (int j = 0; j < 4; ++j) { const float g = acc[ai][0][m][n][j] * rs, uu = acc[ai][1][m][n][j] * rs; o[4 * n + j] = silu_f(g) * uu; }
                u32x4 w; w.x = cvt_pk_bf16(o[0], o[1]); w.y = cvt_pk_bf16(o[2], o[3]); w.z = cvt_pk_bf16(o[4], o[5]); w.w = cvt_pk_bf16(o[6], o[7]);
                *(u32x4*)(ACT + (size_t)row * 2816 + col0) = w;
                asm volatile("" ::: "memory");
            }
    }
};

struct EpiRes {
    static constexpr bool PERM = true, AFTER_DRAIN = false;
    float* H; bf16_t* HB; float* SS; float* OUT; float wres; float* SLAB; unsigned* CNT; __attribute__((address_space(3))) unsigned char* lds_misc; int FINAL; int nsplit;
    __device__ __forceinline__ void operator()(const f32x4 (&acc)[2][2][4][2], const Unit& u, int wr, int wc, int fr, int fq) const {
        const int row0 = u.pm * BM + wr * 64 + fr, col0 = u.pn * BM + wc * 32 + 8 * fq;
        if (SLAB && u.pm == 64) {
            float* sp = SLAB + ((size_t)(u.kt0 / u.nt) * 256 + wr * 64 + fr) * 1024 + col0;
#pragma unroll
            for (int ai = 0; ai < 2; ++ai)
#pragma unroll
                for (int m = 0; m < 4; ++m)
#pragma unroll
                    for (int bj = 0; bj < 2; ++bj) { float* p = sp + (size_t)(ai * HALF + m * 16) * 1024 + bj * HALF; *(f32x4*)p = acc[ai][bj][m][0]; *(f32x4*)(p + 4) = acc[ai][bj][m][1]; }
            volatile __attribute__((address_space(3))) unsigned* lflag = (volatile __attribute__((address_space(3))) unsigned*)(lds_misc);
            asm volatile("s_waitcnt vmcnt(0)" ::: "memory"); __syncthreads();
            if (wr == 0 && wc == 0 && fr == 0 && fq == 0) { __builtin_amdgcn_fence(__ATOMIC_RELEASE, "agent"); asm volatile("s_waitcnt vmcnt(0)" ::: "memory");
                lflag[0] = __hip_atomic_fetch_add(CNT + u.pn, 1u, __ATOMIC_RELAXED, __HIP_MEMORY_SCOPE_AGENT); }
            __syncthreads();
            const bool last = (lflag[0] == (unsigned)(nsplit - 1));
            if (last) {
                __builtin_amdgcn_fence(__ATOMIC_ACQUIRE, "agent"); asm volatile("s_waitcnt vmcnt(0)" ::: "memory");
                const int lane = fq * 16 + fr, wv = wr * 4 + wc;
                constexpr int RB = 4;
                for (int r0 = wv * 16; r0 < wv * 16 + 16; r0 += RB) {
                    f32x4 a[RB]; unsigned long long hw[RB];
#pragma unroll
                    for (int q = 0; q < RB; ++q) {
                        f32x4 sl[11];
#pragma unroll
                        for (int s = 0; s < 11; ++s) sl[s] = s < nsplit ? *((const f32x4*)(SLAB + ((size_t)s * 256 + r0 + q) * 1024 + u.pn * BM) + lane) : (f32x4){0.f, 0.f, 0.f, 0.f};
                        hw[q] = *(const unsigned long long*)(HB + (size_t)(64 * 256 + r0 + q) * 1024 + u.pn * BM + 4 * lane);
                        a[q] = sl[0];
#pragma unroll
                        for (int s = 1; s < 11; ++s) a[q] += sl[s];
                    }
#pragma unroll
                    for (int q = 0; q < RB; ++q) {
                        const int row = 64 * 256 + r0 + q;
                        bf16_t* hbp = HB + (size_t)row * 1024 + u.pn * BM + 4 * lane;
                        const unsigned lo = (unsigned)hw[q], hi2 = (unsigned)(hw[q] >> 32);
                        const f32x4 v = (f32x4){__builtin_bit_cast(float, lo << 16), __builtin_bit_cast(float, lo & 0xffff0000u), __builtin_bit_cast(float, hi2 << 16), __builtin_bit_cast(float, hi2 & 0xffff0000u)} + a[q] * wres;
                        if (FINAL) { const int bb = row / SEQ_L, tt = row - bb * SEQ_L; if (tt >= 16) *((f32x4*)(OUT + ((size_t)bb * 2048 + (tt - 16)) * 1024 + u.pn * BM) + lane) = v; }
                        else { const unsigned w0 = cvt_pk_bf16(v[0], v[1]), w1 = cvt_pk_bf16(v[2], v[3]); *(unsigned long long*)hbp = (unsigned long long)w0 | ((unsigned long long)w1 << 32);
                            const float r0f = __builtin_bit_cast(float, w0 << 16), r1 = __builtin_bit_cast(float, w0 & 0xffff0000u), r2 = __builtin_bit_cast(float, w1 << 16), r3 = __builtin_bit_cast(float, w1 & 0xffff0000u);
                            float ss = (r0f * r0f + r1 * r1) + (r2 * r2 + r3 * r3);
#pragma unroll
                            for (int o = 1; o < 64; o <<= 1) ss += __shfl_xor(ss, o);
                            if (lane < 4) SS[(size_t)row * 16 + u.pn * 4 + lane] = lane == 0 ? ss : 0.f; }
                    }
                }
            }
            return;
        }
#pragma unroll
        for (int ai = 0; ai < 2; ++ai) {
            u32x4 hpre[4][2];
#pragma unroll
            for (int m = 0; m < 4; ++m)
#pragma unroll
                for (int bj = 0; bj < 2; ++bj) hpre[m][bj] = *(const u32x4*)(HB + (size_t)(row0 + ai * HALF + m * 16) * 1024 + col0 + bj * HALF);
#pragma unroll
            for (int m = 0; m < 4; ++m) {
                const int row = row0 + ai * HALF + m * 16; float ss = 0.f;
                bf16_t* hbp = HB + (size_t)row * 1024 + col0;
                const int bb = row / SEQ_L, tt = row - bb * SEQ_L;
#pragma unroll
                for (int bj = 0; bj < 2; ++bj) {
                    const u32x4 hw = hpre[m][bj];
                    const f32x4 h0 = (f32x4){__builtin_bit_cast(float, hw.x << 16), __builtin_bit_cast(float, hw.x & 0xffff0000u), __builtin_bit_cast(float, hw.y << 16), __builtin_bit_cast(float, hw.y & 0xffff0000u)};
                    const f32x4 h1 = (f32x4){__builtin_bit_cast(float, hw.z << 16), __builtin_bit_cast(float, hw.z & 0xffff0000u), __builtin_bit_cast(float, hw.w << 16), __builtin_bit_cast(float, hw.w & 0xffff0000u)};
                    const f32x4 v0 = h0 + acc[ai][bj][m][0] * wres, v1 = h1 + acc[ai][bj][m][1] * wres;
                    if (FINAL) {
                        if (row < M_REAL && tt >= 16) { float* op = OUT + ((size_t)bb * 2048 + (tt - 16)) * 1024 + col0 + bj * HALF; *(f32x4*)op = v0; *(f32x4*)(op + 4) = v1; }
                    } else {
                        u32x4 w; w.x = cvt_pk_bf16(v0[0], v0[1]); w.y = cvt_pk_bf16(v0[2], v0[3]); w.z = cvt_pk_bf16(v1[0], v1[1]); w.w = cvt_pk_bf16(v1[2], v1[3]);
                        *(u32x4*)(hbp + bj * HALF) = w;
                        const float r0 = __builtin_bit_cast(float, w.x << 16), r1 = __builtin_bit_cast(float, w.x & 0xffff0000u), r2 = __builtin_bit_cast(float, w.y << 16), r3 = __builtin_bit_cast(float, w.y & 0xffff0000u);
                        const float r4 = __builtin_bit_cast(float, w.z << 16), r5 = __builtin_bit_cast(float, w.z & 0xffff0000u), r6 = __builtin_bit_cast(float, w.w << 16), r7 = __builtin_bit_cast(float, w.w & 0xffff0000u);
                        ss += (r0 * r0 + r1 * r1) + (r2 * r2 + r3 * r3) + (r4 * r4 + r5 * r5) + (r6 * r6 + r7 * r7);
                    }
                }
                if (!FINAL) { ss += __shfl_xor(ss, 16); ss += __shfl_xor(ss, 32); if (fq == 0) SS[(size_t)row * 16 + u.pn * 4 + wc] = ss; }
            }
            asm volatile("" ::: "memory");
        }
    }
};

struct EpiQKV {
    static constexpr bool PERM = true, AFTER_DRAIN = false;
    bf16_t* QKV; size_t sec_stride; const float* SS; const float* gq; const float* gk; int VT_LP;
    __device__ __forceinline__ void operator()(const f32x4 (&acc)[2][2][4][2], const Unit& u, int wr, int wc, int fr, int fq) const {
        const int row0 = u.pm * BM + wr * 64 + fr; const int sec = u.pn >> 2, pt = u.pn & 3;
        const float* gn = sec == 0 ? gq : gk; bf16_t* dst = QKV + (size_t)sec * sec_stride;
        f32x4 gv[2][2];
#pragma unroll
        for (int bj = 0; bj < 2; ++bj)
#pragma unroll
            for (int n = 0; n < 2; ++n) gv[bj][n] = *(const f32x4*)(gn + 32 * bj + 8 * fq + 4 * n);
        float rs8[2][4]; row_rs8(SS, row0, fq, rs8);
#pragma unroll
        for (int ai = 0; ai < 2; ++ai)
#pragma unroll
            for (int m = 0; m < 4; ++m) {
                const int row = row0 + ai * HALF + m * 16; const float rs = rs8[ai][m];
                const int bb = row / SEQ_L, tt = row - bb * SEQ_L;
                f32x4 x[2][2];
#pragma unroll
                for (int bj = 0; bj < 2; ++bj)
#pragma unroll
                    for (int n = 0; n < 2; ++n) x[bj][n] = acc[ai][bj][m][n] * rs;
                if (sec < 2) {
                    float ss = 0.f;
#pragma unroll
                    for (int bj = 0; bj < 2; ++bj)
#pragma unroll
                        for (int n = 0; n < 2; ++n) ss += (x[bj][n][0] * x[bj][n][0] + x[bj][n][1] * x[bj][n][1]) + (x[bj][n][2] * x[bj][n][2] + x[bj][n][3] * x[bj][n][3]);
                    ss += __shfl_xor(ss, 16); ss += __shfl_xor(ss, 32);
                    const float r = __builtin_amdgcn_rsqf(ss * (1.0f / 64.0f) + RMS_EPS);
#pragma unroll
                    for (int bj = 0; bj < 2; ++bj)
#pragma unroll
                        for (int n = 0; n < 2; ++n) x[bj][n] = x[bj][n] * r * gv[bj][n];
                }
                if (row < M_REAL && sec == 2 && VT_LP) {
                    const int kt = tt >> 5, s = (tt >> 4) & 1, k16 = tt & 15, hl = (k16 >> 2) & 1, jj = (k16 & 3) + 4 * (k16 >> 3);
#pragma unroll
                    for (int bj = 0; bj < 2; ++bj) {
                        const int c = 256 * pt + 128 * bj + 32 * wc + 8 * fq, head = c >> 6, dim = c & 63;
                        bf16_t* vp = dst + (((size_t)(bb * 16 + head) * 65 + kt) * 2 + (dim >> 5)) * 1024 + ((dim & 31) + 32 * hl) * 16 + 8 * s + jj;
#pragma unroll
                        for (int n = 0; n < 2; ++n)
#pragma unroll
                            for (int i = 0; i < 4; ++i) vp[(4 * n + i) * 16] = (bf16_t)(cvt_pk_bf16(x[bj][n][i], x[bj][n][i]) & 0xffffu);
                    }
                } else if (row < M_REAL) {
#pragma unroll
                    for (int bj = 0; bj < 2; ++bj) {
                        int head, dim;
                        if (sec < 2) { head = 4 * pt + wc; dim = 32 * bj + 8 * fq; }
                        else { const int c = 256 * pt + 128 * bj + 32 * wc + 8 * fq; head = c >> 6; dim = c & 63; }
                        u32x4 w; w.x = cvt_pk_bf16(x[bj][0][0], x[bj][0][1]); w.y = cvt_pk_bf16(x[bj][0][2], x[bj][0][3]); w.z = cvt_pk_bf16(x[bj][1][0], x[bj][1][1]); w.w = cvt_pk_bf16(x[bj][1][2], x[bj][1][3]);
                        *(u32x4*)(dst + ((size_t)(bb * 16 + head) * SEQ_L + tt) * 64 + dim) = w;
                    }
                }
                asm volatile("" ::: "memory");
            }
    }
};

struct EpiGLAIn {
    static constexpr bool PERM = true, AFTER_DRAIN = false;
    bf16_t* P; float* GL; const float* SS;
    __device__ __forceinline__ void operator()(const f32x4 (&acc)[2][2][4][2], const Unit& u, int wr, int wc, int fr, int fq) const {
        const int row0 = u.pm * BM + wr * 64 + fr, col0 = u.pn * BM + wc * 32 + 8 * fq;
        float rs8[2][4]; row_rs8(SS, row0, fq, rs8);
#pragma unroll
        for (int ai = 0; ai < 2; ++ai)
#pragma unroll
            for (int m = 0; m < 4; ++m) {
                const int row = row0 + ai * HALF + m * 16; const float rs = rs8[ai][m];
                if (u.pn < 12) {
#pragma unroll
                    for (int bj = 0; bj < 2; ++bj) {
                        const f32x4 v0 = acc[ai][bj][m][0] * rs, v1 = acc[ai][bj][m][1] * rs;
                        u32x4 w; w.x = cvt_pk_bf16(v0[0], v0[1]); w.y = cvt_pk_bf16(v0[2], v0[3]); w.z = cvt_pk_bf16(v1[0], v1[1]); w.w = cvt_pk_bf16(v1[2], v1[3]);
                        *(u32x4*)(P + (size_t)row * 3072 + col0 + bj * HALF) = w;
                    }
                } else if (wc == 0 && fq < 2) {
                    const f32x4 v0 = acc[ai][0][m][0] * rs, v1 = acc[ai][0][m][1] * rs;
                    *(f32x4*)(GL + (size_t)row * 16 + 8 * fq) = v0; *(f32x4*)(GL + (size_t)row * 16 + 8 * fq + 4) = v1;
                }
                asm volatile("" ::: "memory");
            }
    }
};

struct EpiAny {
    static constexpr bool PERM = true, AFTER_DRAIN = false;
    int kind; EpiGU gu; EpiQKV qkv; EpiGLAIn gin;
    __device__ __forceinline__ void operator()(const f32x4 (&acc)[2][2][4][2], const Unit& u, int wr, int wc, int fr, int fq) const {
        if (kind == 0) gu(acc, u, wr, wc, fr, fq); else if (kind == 1) qkv(acc, u, wr, wc, fr, fq); else gin(acc, u, wr, wc, fr, fq);
    }
};
template <class Epi, class Sched, bool ALIGN_EPI = false, bool SP2 = false>
__device__ __forceinline__ void gemm_phase(PG8_LAS unsigned char* lds, const Gemm g, const Sched& S, const Epi& E) {
    int tid_ = threadIdx.x; asm volatile("" : "+v"(tid_)); const int tid = tid_, wid = __builtin_amdgcn_readfirstlane(tid >> 6), lane = tid & 63, wr = wid >> 2, wc = wid & 3, fr = lane & 15, fq = lane >> 4;
    const int K = g.K;
    unsigned voffA[2], voffB[2];
#pragma unroll
    for (int i = 0; i < 2; ++i) { int R, C; stage_rc(tid * 16 + i * 8192, R, C); const int Rb = Epi::PERM ? ((R & ~31) + perm32(R & 31)) : R;
        voffA[i] = (unsigned)(R * K + C) * 2u; voffB[i] = (unsigned)(Rb * K + C) * 2u; }
    const size_t kstep = (size_t)(BK * 2);
    const size_t hstep = (size_t)HALF * K * 2;
    const size_t tstep = 2 * hstep;
    const unsigned ldsw = (unsigned)wid * 1024u;
    const int aoff = lds_byte(wr * 64 + fr, fq * 8), boff = lds_byte(wc * 32 + fr, fq * 8);
#define PG8_SA(b, h) (((b) * 2 + (h)) * HTB)
#define PG8_SB(b, h) ((4 + (b) * 2 + (h)) * HTB)
#define PG8_STAGE(bufoff, gbase, voff) do { _Pragma("unroll") for (int _i = 0; _i < 2; ++_i) \
        __builtin_amdgcn_global_load_lds((const unsigned*)((const char*)(gbase) + (voff)[_i]), (PG8_LAS unsigned*)(lds + (bufoff) + ldsw + _i * 8192), 16, 0, 0); } while (0)
#define PG8_LDA(dst, b, h) do { _Pragma("unroll") for (int m = 0; m < 4; ++m) _Pragma("unroll") for (int k = 0; k < 2; ++k) dst[m][k] = *(const PG8_LAS bf16x8*)(lds + PG8_SA(b, h) + aoff + m * 2048 + k * 1024); } while (0)
#define PG8_LDB(dst, b, h) do { _Pragma("unroll") for (int n = 0; n < 2; ++n) _Pragma("unroll") for (int k = 0; k < 2; ++k) dst[n][k] = *(const PG8_LAS bf16x8*)(lds + PG8_SB(b, h) + boff + n * 2048 + k * 1024); } while (0)
#define PG8_MMA(ai, bj, At, Bt) do { __builtin_amdgcn_s_setprio(1); _Pragma("unroll") for (int m = 0; m < 4; ++m) _Pragma("unroll") for (int n = 0; n < 2; ++n) _Pragma("unroll") for (int k = 0; k < 2; ++k) \
        acc[ai][bj][m][n] = __builtin_amdgcn_mfma_f32_16x16x32_bf16(Bt[n][k], At[m][k], acc[ai][bj][m][n], 0, 0, 0); __builtin_amdgcn_s_setprio(0); } while (0)
#define PG8_WAIT_V(n) asm volatile("s_waitcnt vmcnt(" #n ")" ::: "memory")
#define PG8_WAIT_L(n) asm volatile("s_waitcnt lgkmcnt(" #n ")" ::: "memory")
#define PG8_BAR __builtin_amdgcn_s_barrier()
#define PG8_SCHED __builtin_amdgcn_sched_barrier(0)
    Unit cur, nxt; int ui = 0;
    if (!S.next(0, cur)) return;
    f32x4 acc[2][2][4][2];
#pragma unroll
    for (int a = 0; a < 2; ++a)
#pragma unroll
        for (int b = 0; b < 2; ++b)
#pragma unroll
            for (int m = 0; m < 4; ++m)
#pragma unroll
                for (int n = 0; n < 2; ++n) acc[a][b][m][n] = (f32x4){0.f, 0.f, 0.f, 0.f};
    bf16x8 At[4][2], B0[2][2], B1[2][2];
    const char* cA = (const char*)g.A + (size_t)cur.pm * tstep + (size_t)cur.kt0 * kstep; const char* cB = (const char*)g.Bt + (size_t)cur.pn * tstep + (size_t)cur.kt0 * kstep;
    S.a_ready(cur);
    if constexpr (SP2) {
        PG8_STAGE(PG8_SB(0, 0), cB, voffB); PG8_STAGE(PG8_SB(0, 1), cB + hstep, voffB); PG8_STAGE(PG8_SA(0, 0), cA, voffA); PG8_STAGE(PG8_SA(0, 1), cA + hstep, voffA);
        if (wr == 1) PG8_BAR;
        PG8_WAIT_V(2); PG8_BAR;
        PG8_STAGE(PG8_SB(1, 0), cB + kstep, voffB); PG8_STAGE(PG8_SA(1, 0), cA + kstep, voffA); PG8_STAGE(PG8_SB(1, 1), cB + hstep + kstep, voffB);
        PG8_WAIT_V(6); PG8_BAR;
    } else {
        PG8_STAGE(PG8_SB(0, 0), cB, voffB); PG8_STAGE(PG8_SA(0, 0), cA, voffA); PG8_STAGE(PG8_SB(0, 1), cB + hstep, voffB); PG8_STAGE(PG8_SA(0, 1), cA + hstep, voffA);
        if (wr == 1) PG8_BAR;
        PG8_WAIT_V(4); PG8_BAR;
        PG8_STAGE(PG8_SB(1, 0), cB + kstep, voffB); PG8_STAGE(PG8_SA(1, 0), cA + kstep, voffA); PG8_STAGE(PG8_SB(1, 1), cB + hstep + kstep, voffB);
        PG8_WAIT_V(6); PG8_BAR;
    }
    for (;;) {
        const bool has_next = S.next(ui + 1, nxt);
        const char* nA = has_next ? (const char*)g.A + (size_t)nxt.pm * tstep + (size_t)nxt.kt0 * kstep : cA; const char* nB = has_next ? (const char*)g.Bt + (size_t)nxt.pn * tstep + (size_t)nxt.kt0 * kstep : cB;
        const int nt = cur.nt;
        for (int t = 0; t < nt; t += 2) {
            const bool last = (t == nt - 2);
            const char* a1 = cA + (size_t)(t + 1) * kstep;
            const char* a2 = last ? nA : cA + (size_t)(t + 2) * kstep; const char* b2 = last ? nB : cB + (size_t)(t + 2) * kstep;
            const char* a3 = a2 + kstep; const char* b3 = b2 + kstep;
            if (last && has_next) S.a_ready(nxt);
            if constexpr (SP2) {
            PG8_LDB(B0, 0, 0); PG8_LDB(B1, 0, 1); PG8_SCHED; PG8_LDA(At, 0, 0); PG8_STAGE(PG8_SA(1, 1), a1 + hstep, voffA);
            PG8_WAIT_V(8); PG8_WAIT_L(0); PG8_BAR; PG8_MMA(0, 0, At, B0); PG8_MMA(0, 1, At, B1); PG8_BAR; PG8_SCHED;
            PG8_LDA(At, 0, 1); PG8_STAGE(PG8_SB(0, 0), b2, voffB); PG8_STAGE(PG8_SB(0, 1), b2 + hstep, voffB); PG8_STAGE(PG8_SA(0, 0), a2, voffA);
            PG8_WAIT_V(8); PG8_WAIT_L(0); PG8_BAR; PG8_MMA(1, 0, At, B0); PG8_MMA(1, 1, At, B1); PG8_BAR; PG8_SCHED;
            PG8_LDB(B0, 1, 0); PG8_LDB(B1, 1, 1); PG8_SCHED; PG8_LDA(At, 1, 0); PG8_STAGE(PG8_SA(0, 1), a2 + hstep, voffA);
            PG8_WAIT_V(8); PG8_WAIT_L(0); PG8_BAR; PG8_MMA(0, 0, At, B0); PG8_MMA(0, 1, At, B1); PG8_BAR; PG8_SCHED;
            PG8_LDA(At, 1, 1); PG8_STAGE(PG8_SB(1, 0), b3, voffB); PG8_STAGE(PG8_SB(1, 1), b3 + hstep, voffB); PG8_STAGE(PG8_SA(1, 0), a3, voffA);
            PG8_WAIT_V(8); PG8_WAIT_L(0); PG8_BAR; PG8_MMA(1, 0, At, B0); PG8_MMA(1, 1, At, B1); PG8_BAR; PG8_SCHED;
            } else {
            PG8_LDB(B0, 0, 0); PG8_SCHED; PG8_LDA(At, 0, 0); PG8_STAGE(PG8_SA(1, 1), a1 + hstep, voffA);
            PG8_WAIT_L(8); PG8_BAR; PG8_WAIT_L(0); PG8_MMA(0, 0, At, B0); PG8_BAR; PG8_SCHED;
            PG8_LDB(B1, 0, 1); PG8_STAGE(PG8_SB(0, 0), b2, voffB);
            PG8_BAR; PG8_WAIT_L(0); PG8_MMA(0, 1, At, B1); PG8_BAR;
            PG8_LDA(At, 0, 1); PG8_STAGE(PG8_SA(0, 0), a2, voffA);
            PG8_BAR; PG8_WAIT_L(0); PG8_MMA(1, 0, At, B0); PG8_BAR; PG8_SCHED;
            PG8_STAGE(PG8_SB(0, 1), b2 + hstep, voffB);
            PG8_WAIT_V(6); PG8_BAR; PG8_MMA(1, 1, At, B1); PG8_BAR;
            PG8_LDB(B0, 1, 0); PG8_SCHED; PG8_LDA(At, 1, 0); PG8_STAGE(PG8_SA(0, 1), a2 + hstep, voffA);
            PG8_WAIT_L(8); PG8_BAR; PG8_WAIT_L(0); PG8_MMA(0, 0, At, B0); PG8_BAR; PG8_SCHED;
            PG8_LDB(B1, 1, 1); PG8_STAGE(PG8_SB(1, 0), b3, voffB);
            PG8_BAR; PG8_WAIT_L(0); PG8_MMA(0, 1, At, B1); PG8_BAR;
            PG8_LDA(At, 1, 1); PG8_STAGE(PG8_SA(1, 0), a3, voffA);
            PG8_BAR; PG8_WAIT_L(0); PG8_MMA(1, 0, At, B0); PG8_BAR; PG8_SCHED;
            PG8_STAGE(PG8_SB(1, 1), b3 + hstep, voffB);
            PG8_WAIT_V(6); PG8_BAR; PG8_MMA(1, 1, At, B1); PG8_BAR;
            }
        }
        if constexpr (ALIGN_EPI) { if (wr == 0) PG8_BAR; }
        if constexpr (!Epi::AFTER_DRAIN) { E(acc, cur, wr, wc, fr, fq); S.done(cur); }
        if (!has_next) break;
#pragma unroll
        for (int a = 0; a < 2; ++a)
#pragma unroll
            for (int b = 0; b < 2; ++b)
#pragma unroll
                for (int m = 0; m < 4; ++m)
#pragma unroll
                    for (int n = 0; n < 2; ++n) acc[a][b][m][n] = (f32x4){0.f, 0.f, 0.f, 0.f};
        cur = nxt; cA = nA; cB = nB; ++ui;
        if constexpr (ALIGN_EPI) { if (wr == 1) PG8_BAR; }
    }
    PG8_WAIT_V(0);
    if constexpr (!ALIGN_EPI) { if (wr == 0) PG8_BAR; }
    PG8_BAR;
    if constexpr (Epi::AFTER_DRAIN) { E.fused(acc, cur, wr, wc, fr, fq, lds, wid, lane); S.done(cur); }
#undef PG8_SA
#undef PG8_SB
#undef PG8_STAGE
#undef PG8_LDA
#undef PG8_LDB
#undef PG8_MMA
#undef PG8_WAIT_V
#undef PG8_WAIT_L
#undef PG8_BAR
#undef PG8_SCHED
}
}
namespace cg = cooperative_groups;
#define LAS __attribute__((address_space(3)))
typedef unsigned short bf16;
typedef unsigned v4u __attribute__((ext_vector_type(4)));
typedef unsigned v2u __attribute__((ext_vector_type(2)));
typedef float f32x4 __attribute__((ext_vector_type(4)));
constexpr int NWAVES = 8, NTHR = 512;
constexpr int NB = 8, SEQ = 2048, NMETA = 16, L = 2064, D = 1024, FF = 2816, DEPTH = 4;
constexpr int M = NB * L;
constexpr int MP = 16640;
constexpr int GLA_IN = 3088, GLA_INP = 3328;
constexpr size_t MiB = 1u << 20;
constexpr size_t WS_SS = 1 * MiB, WS_H = 3 * MiB, WS_HB = 68 * MiB;
constexpr size_t WS_WGUA = 101 * MiB, WS_WDA = 112 * MiB, WS_WGUB = 118 * MiB, WS_WDB = 129 * MiB, WS_WMIX = 135 * MiB, WS_WO = 142 * MiB;
constexpr size_t WS_ACT = 144 * MiB;
constexpr size_t WS_Q = 144 * MiB, WS_K = 177 * MiB, WS_V = 210 * MiB, WS_O = 243 * MiB;
constexpr size_t WS_GP = 144 * MiB, WS_GGL = 242 * MiB, WS_GA = 244 * MiB, WS_GOG = 277 * MiB, WS_GGA = 343 * MiB, WS_SLAB = 376 * MiB, WS_END = 388 * MiB;
static_assert(WS_V - WS_K == WS_K - WS_Q, "Q|K|V equally spaced");
constexpr int LDS_BYTES = 147456;

__device__ __forceinline__ unsigned f2bf(float f) { unsigned u = __builtin_bit_cast(unsigned, f); return (u + 0x7fffu + ((u >> 16) & 1u)) >> 16; }
typedef float f32x2_t __attribute__((ext_vector_type(2))); typedef __bf16 bf16x2_t __attribute__((ext_vector_type(2)));
__device__ __forceinline__ unsigned pk2(float lo, float hi) { const f32x2_t v = {lo, hi}; return __builtin_bit_cast(unsigned, __builtin_convertvector(v, bf16x2_t)); }
__device__ __forceinline__ float bflo(unsigned u) { return __builtin_bit_cast(float, u << 16); }
__device__ __forceinline__ float bfhi(unsigned u) { return __builtin_bit_cast(float, u & 0xffff0000u); }
__device__ __forceinline__ float wave_sum(float v) {
#pragma unroll
    for (int o = 1; o < 64; o <<= 1) v += __shfl_xor(v, o);
    return v;
}

constexpr size_t WS_CTL = 0, CTL_ZERO_BYTES = 65536; constexpr int CW_BAR = 4096, CW_CNT = 8192;
typedef __attribute__((address_space(1))) unsigned gu32;
#define XB_TMO      128
#define XB_XCNT(j)  (256  + 64 * (j))
#define XB_XSUB(j)  (1280 + 64 * (j))
#define XB_XGEN(j)  (2304 + 64 * (j))
#define XB_TOP      3328
#define XB_TOPGEN   3392
#define XCD_BAR_WORDS 3456
#define XB_SPIN_CAP (1u << 18)

__device__ __forceinline__ unsigned xb_ld(unsigned* p)              { return __hip_atomic_load(p, __ATOMIC_RELAXED, __HIP_MEMORY_SCOPE_AGENT); }
__device__ __forceinline__ unsigned xb_add(unsigned* p, unsigned v) { return __hip_atomic_fetch_add(p, v, __ATOMIC_RELAXED, __HIP_MEMORY_SCOPE_AGENT); }
__device__ __forceinline__ unsigned xb_xcc_id() { return (unsigned)__builtin_amdgcn_s_getreg((3 << 11) | 20) & 0xFu; }
#define XB_SPIN(cond, bar) do { unsigned _sp = 0; while (cond) { __builtin_amdgcn_s_sleep(1); \
    if ((++_sp & 255u) == 0u) { if (xb_ld(&(bar)[XB_TMO])) break; if (_sp > XB_SPIN_CAP) { atomicAdd(&(bar)[XB_TMO], 1u); break; } } } } while (0)

struct XcdBarrier {
    unsigned* bar; unsigned x;
    volatile LAS unsigned* st;
};

__device__ __forceinline__ XcdBarrier xcd_barrier_post(unsigned* bar, volatile LAS unsigned* st) {
    XcdBarrier b; b.bar = bar; b.x = xb_xcc_id(); b.st = st;
    if (threadIdx.x == 0) (void)xb_add(&bar[XB_XCNT(b.x)], 1u);
    return b;
}
__device__ __forceinline__ void xcd_barrier_complete(unsigned* bar, unsigned x, unsigned& nloc, unsigned& nx) {
    const unsigned G = gridDim.x * gridDim.y * gridDim.z;
    unsigned sum, cnt, mine, sp = 0u;
    for (;;) {
        sum = 0u; cnt = 0u; mine = 0u;
#pragma unroll
        for (unsigned j = 0; j < 16; ++j) { const unsigned c = xb_ld(&bar[XB_XCNT(j)]); sum += c; cnt += (c > 0u) ? 1u : 0u; mine = (j == x) ? c : mine; }
        if (sum == G) break;
        __builtin_amdgcn_s_sleep(1);
        if ((++sp & 255u) == 0u) { if (xb_ld(&bar[XB_TMO])) break; if (sp > XB_SPIN_CAP) { atomicAdd(&bar[XB_TMO], 1u); break; } }
    }
    nloc = mine > 0u ? mine : 1u; nx = cnt > 0u ? cnt : 1u;
}

__device__ __forceinline__ void xcd_barrier(const XcdBarrier& b) {
    asm volatile("s_waitcnt vmcnt(0)" ::: "memory");
    __syncthreads();
    if (threadIdx.x == 0) {
        unsigned* bar = b.bar;
        __builtin_amdgcn_s_waitcnt(0);
        unsigned nloc = b.st[0], nx = b.st[1];
        if (nloc == 0u) { xcd_barrier_complete(bar, b.x, nloc, nx); b.st[0] = nloc; b.st[1] = nx; }
        const unsigned old = xb_add(&bar[XB_XSUB(b.x)], 1u);
        const unsigned gen = old / nloc;
        if (old + 1u == (gen + 1u) * nloc) {
            __builtin_amdgcn_fence(__ATOMIC_RELEASE, "agent");
            asm volatile("s_waitcnt vmcnt(0)" ::: "memory");
            const unsigned og = xb_add(&bar[XB_TOP], 1u);
            const unsigned tg = og / nx;
            if (og + 1u == (tg + 1u) * nx) xb_add(&bar[XB_TOPGEN], 1u);
            else XB_SPIN(xb_ld(&bar[XB_TOPGEN]) == tg, bar);
            __builtin_amdgcn_fence(__ATOMIC_ACQUIRE, "agent");
            xb_add(&bar[XB_XGEN(b.x)], 1u);
            asm volatile("s_waitcnt vmcnt(0)" ::: "memory");
        } else {
            XB_SPIN(xb_ld(&bar[XB_XGEN(b.x)]) == gen, bar);
            __builtin_amdgcn_fence(__ATOMIC_ACQUIRE, "agent");
            asm volatile("s_waitcnt vmcnt(0)" ::: "memory");
        }
    }
    __syncthreads();
}

struct Args { const float* in[18]; float* out; unsigned char* ws; };
typedef const __attribute__((address_space(4))) unsigned char* kptr_t;
__device__ __forceinline__ unsigned long long karg(int i) { kptr_t ka = (kptr_t)__builtin_amdgcn_kernarg_segment_ptr(); asm volatile("" : "+s"(ka)); return *(const __attribute__((address_space(4))) unsigned long long*)(ka + 8 * i); }
#define KIN(i) ((const float*)(const __attribute__((address_space(1))) float*)karg(i))
#define KOUT ((float*)(__attribute__((address_space(1))) float*)karg(18))
#define KWS ((unsigned char*)(__attribute__((address_space(1))) unsigned char*)karg(19))

struct ConvP { const float* src; const float* gain; bf16* dst; int ldw, K; };
__device__ __forceinline__ int gu_dest(int c) { return c < FF ? 256 * (c >> 7) + (c & 127) : 256 * ((c - FF) >> 7) + 128 + ((c - FF) & 127); }
__device__ __forceinline__ int qkv_dest(int c) {
    const int sec = c >> 10, cc = c & 1023; if (sec == 2) return c;
    const int head = cc >> 6, dd = cc & 63; return 1024 * sec + 256 * (head >> 2) + 128 * (dd >> 5) + 32 * (head & 3) + (dd & 31);
}
constexpr int CONV_I_GU = 16 * 176, CONV_I_D = 44 * 32, CONV_I_IN = 16 * 96, CONV_I_O = 16 * 32, CONV_NIT = 2 * (CONV_I_GU + CONV_I_D) + CONV_I_IN + CONV_I_O;
__device__ __forceinline__ ConvP conv_params(int it, int layer, unsigned char* ws) {
    const int j = layer >> 1; const bool sb = (layer & 1) == 0;
    const float* W; const float* gain = nullptr; bf16* WT; int ldw, K, kb, nb, dest0;
    int r = it;
    if (r < CONV_I_GU) { kb = r / 176; nb = r % 176; W = KIN(3) + (size_t)layer * D * 2 * FF; ldw = 2 * FF; K = D; WT = (bf16*)(ws + WS_WGUA); dest0 = gu_dest(32 * nb); gain = KIN(2) + layer * D; }
    else if ((r -= CONV_I_GU) < CONV_I_D) { kb = r / 32; nb = r % 32; W = KIN(4) + (size_t)layer * FF * D; ldw = D; K = FF; WT = (bf16*)(ws + WS_WDA); dest0 = 32 * nb; }
    else if ((r -= CONV_I_D) < CONV_I_GU) { kb = r / 176; nb = r % 176; W = KIN(16) + (size_t)layer * D * 2 * FF; ldw = 2 * FF; K = D; WT = (bf16*)(ws + WS_WGUB); dest0 = gu_dest(32 * nb); gain = KIN(15) + layer * D; }
    else if ((r -= CONV_I_GU) < CONV_I_D) { kb = r / 32; nb = r % 32; W = KIN(17) + (size_t)layer * FF * D; ldw = D; K = FF; WT = (bf16*)(ws + WS_WDB); dest0 = 32 * nb; }
    else if ((r -= CONV_I_D) < CONV_I_IN) { kb = r / 96; nb = r % 96; K = D; WT = (bf16*)(ws + WS_WMIX); gain = KIN(5) + layer * D;
        if (sb) { W = KIN(6) + (size_t)j * D * 3 * D; ldw = 3 * D; dest0 = qkv_dest(32 * nb); } else { W = KIN(10) + (size_t)j * D * GLA_IN; ldw = GLA_IN; dest0 = 32 * nb; } }
    else { r -= CONV_I_IN; kb = r / 32; nb = r % 32; W = (sb ? KIN(9) : KIN(14)) + (size_t)j * D * D; ldw = D; K = D; WT = (bf16*)(ws + WS_WO); dest0 = 32 * nb; }
    ConvP p; p.src = W + (size_t)(64 * kb) * ldw + 32 * nb; p.gain = gain ? gain + 64 * kb : nullptr; p.dst = WT + (size_t)dest0 * K + 64 * kb; p.ldw = ldw; p.K = K; return p;
}
__device__ __forceinline__ void conv_load(const ConvP& p, int lane, f32x4 (&v)[8], float (&g)[8]) {
    const int c4 = lane & 7, r8 = lane >> 3;
#pragma unroll
    for (int i = 0; i < 8; ++i) { v[i] = *(const f32x4*)(p.src + (size_t)(8 * i + r8) * p.ldw + 4 * c4); g[i] = p.gain ? p.gain[8 * i + r8] : 1.0f; }
}
__device__ __forceinline__ void conv_store(const ConvP& p, int lane, const f32x4 (&v)[8], const float (&g)[8], LAS float* scr) {
    const int c4 = lane & 7, r8 = lane >> 3;
#pragma unroll
    for (int i = 0; i < 8; ++i) { LAS float* s = scr + (8 * i + r8) * 33 + 4 * c4; s[0] = v[i][0] * g[i]; s[1] = v[i][1] * g[i]; s[2] = v[i][2] * g[i]; s[3] = v[i][3] * g[i]; }
    asm volatile("s_waitcnt lgkmcnt(0)" ::: "memory");
    const int c = lane & 7;
#pragma unroll
    for (int jj = 0; jj < 4; ++jj) { const int n = (lane >> 3) + 8 * jj; const LAS float* s = scr + (8 * c) * 33 + n;
        v4u o; o.x = pk2(s[0 * 33], s[1 * 33]); o.y = pk2(s[2 * 33], s[3 * 33]); o.z = pk2(s[4 * 33], s[5 * 33]); o.w = pk2(s[6 * 33], s[7 * 33]);
        *(v4u*)(p.dst + (size_t)n * p.K + 8 * c) = o; }
    asm volatile("s_waitcnt lgkmcnt(0)" ::: "memory");
}
__device__ __forceinline__ int conv_item_index(int ci, int part) {
    constexpr int AB = CONV_I_GU + CONV_I_D;
    return part == 0 ? (ci < AB ? ci : ci + AB) : part == 1 ? ci + AB : (part == 2 || part == 5) ? ci : ci + 2 * AB;
}
__device__ __forceinline__ void conv_phase(const Args& a, unsigned char* ws, int layer, int part, LAS unsigned char* lds, int gw, int NGW, int wave, int lane, int gtid, int GT) {
    LAS float* scr = (LAS float*)(lds + wave * 16384);
    const int j = layer >> 1; const bool sb = (layer & 1) == 0;
    constexpr int AB = CONV_I_GU + CONV_I_D;
    const int ncomp = part == 0 ? CONV_NIT - AB : part == 3 ? CONV_I_IN + CONV_I_O : AB;
    if (gw < ncomp) {
        ConvP cur = conv_params(conv_item_index(gw, part), layer, ws); f32x4 v[8]; float g[8];
        conv_load(cur, lane, v, g);
#pragma unroll 1
        for (int ci = gw; ci < ncomp; ci += NGW) {
            const bool has = ci + NGW < ncomp;
            ConvP nxt = conv_params(conv_item_index(has ? ci + NGW : ci, part), layer, ws); f32x4 vn[8]; float gn[8];
            conv_load(nxt, lane, vn, gn);
            conv_store(cur, lane, v, g, scr);
            cur = nxt;
#pragma unroll
            for (int i = 0; i < 8; ++i) { v[i] = vn[i]; g[i] = gn[i]; }
        }
    }
    if (!sb && (part == 0 || part == 3)) {
        const float* W = KIN(10) + (size_t)j * D * GLA_IN; const float* gain = KIN(5) + layer * D; bf16* WT = (bf16*)(ws + WS_WMIX) + (size_t)3072 * D;
        for (int idx = gtid; idx < 256 * D; idx += GT) { const int r = idx >> 10, k = idx & 1023; WT[idx] = (bf16)(r < 16 ? f2bf(W[(size_t)k * GLA_IN + 3072 + r] * gain[k]) : 0u); }
    }
}

__device__ __forceinline__ void prologue_rows(const Args& a, unsigned char* ws, int gw, int NGW, int lane) {
    float* H = (float*)(ws + WS_H); bf16* HB = (bf16*)(ws + WS_HB); float* SS = (float*)(ws + WS_SS);
    for (int m = gw; m < MP; m += NGW) {
        f32x4 v[4]; float s = 0.f;
        if (m < M) { const int b = m / L, t = m - b * L; const float* src = t < NMETA ? KIN(1) + (size_t)t * D : KIN(0) + ((size_t)b * SEQ + (t - NMETA)) * D;
#pragma unroll
            for (int j = 0; j < 4; ++j) { v[j] = *((const f32x4*)src + lane + 64 * j); s += (v[j][0] * v[j][0] + v[j][1] * v[j][1]) + (v[j][2] * v[j][2] + v[j][3] * v[j][3]); }
        } else {
#pragma unroll
            for (int j = 0; j < 4; ++j) v[j] = (f32x4){0.f, 0.f, 0.f, 0.f};
        }
        s = 0.f;
#pragma unroll
        for (int j = 0; j < 4; ++j) { v2u w; w.x = pk2(v[j][0], v[j][1]); w.y = pk2(v[j][2], v[j][3]); *((v2u*)(HB + (size_t)m * D) + lane + 64 * j) = w;
            const float r0 = bflo(w.x), r1 = bfhi(w.x), r2 = bflo(w.y), r3 = bfhi(w.y); s += (r0 * r0 + r1 * r1) + (r2 * r2 + r3 * r3); }
        s = wave_sum(s);
        if (lane < 16) SS[(size_t)m * 16 + lane] = lane == 0 ? s : 0.f;
    }
}

__device__ __forceinline__ void sb_attn_phase(const bf16* Q, const bf16* K, const bf16* V, bf16* O, int gw, int NGW, int lane) {
    constexpr int NQB = (L + 63) / 64;
    for (int wu = gw; wu < NB * 16 * NQB; wu += NGW) {
        const int bh = wu / NQB, qb = wu - bh * NQB; const int t = qb * 64 + lane; const bool valid = t < L;
        const size_t base = (size_t)bh * L * 64;
        float q[64], o[64];
        if (valid) {
            const v4u* qp = (const v4u*)(Q + base + (size_t)t * 64);
#pragma unroll
            for (int c = 0; c < 8; ++c) { const v4u r = qp[c];
                q[8 * c + 0] = bflo(r.x) * 0.125f; q[8 * c + 1] = bfhi(r.x) * 0.125f; q[8 * c + 2] = bflo(r.y) * 0.125f; q[8 * c + 3] = bfhi(r.y) * 0.125f;
                q[8 * c + 4] = bflo(r.z) * 0.125f; q[8 * c + 5] = bfhi(r.z) * 0.125f; q[8 * c + 6] = bflo(r.w) * 0.125f; q[8 * c + 7] = bfhi(r.w) * 0.125f; }
        } else {
#pragma unroll
            for (int c = 0; c < 64; ++c) q[c] = 0.f;
        }
#pragma unroll
        for (int c = 0; c < 64; ++c) o[c] = 0.f;
        float carry = 0.f;
        for (int i = 1; i < L; ++i) {
            const int s = t - i; const bool act = valid && s >= 0 && carry > -104.0f;
            if (__ballot(act) == 0ull) break;
            if (act) {
                const v4u* kp = (const v4u*)(K + base + (size_t)s * 64);
                float z0 = 0.f, z1 = 0.f;
#pragma unroll
                for (int c = 0; c < 8; ++c) { const v4u r = kp[c];
                    z0 += q[8 * c + 0] * bflo(r.x); z1 += q[8 * c + 1] * bfhi(r.x); z0 += q[8 * c + 2] * bflo(r.y); z1 += q[8 * c + 3] * bfhi(r.y);
                    z0 += q[8 * c + 4] * bflo(r.z); z1 += q[8 * c + 5] * bfhi(r.z); z0 += q[8 * c + 6] * bflo(r.w); z1 += q[8 * c + 7] * bfhi(r.w); }
                const float z = z0 + z1;
                const float sp = fmaxf(z, 0.f) + __logf(1.0f + __expf(-fabsf(z)));
                const float w = __expf(z - sp + carry);
                carry -= sp;
                const v4u* vp = (const v4u*)(V + base + (size_t)s * 64);
#pragma unroll
                for (int c = 0; c < 8; ++c) { const v4u r = vp[c];
                    o[8 * c + 0] += w * bflo(r.x); o[8 * c + 1] += w * bfhi(r.x); o[8 * c + 2] += w * bflo(r.y); o[8 * c + 3] += w * bfhi(r.y);
                    o[8 * c + 4] += w * bflo(r.z); o[8 * c + 5] += w * bfhi(r.z); o[8 * c + 6] += w * bflo(r.w); o[8 * c + 7] += w * bfhi(r.w); }
            }
        }
        if (valid) {
            const int b = bh >> 4, h = bh & 15;
            v4u* op = (v4u*)(O + ((size_t)b * L + t) * D + h * 64);
#pragma unroll
            for (int c = 0; c < 8; ++c) { v4u w; w.x = pk2(o[8 * c + 0], o[8 * c + 1]); w.y = pk2(o[8 * c + 2], o[8 * c + 3]); w.z = pk2(o[8 * c + 4], o[8 * c + 5]); w.w = pk2(o[8 * c + 6], o[8 * c + 7]); op[c] = w; }
        }
    }
}


typedef short bf16x8_t __attribute__((ext_vector_type(8)));
typedef float f32x16 __attribute__((ext_vector_type(16)));
constexpr int SB_LP = 2080;
__device__ __forceinline__ void sb_attn_mfma(const bf16* Q, const bf16* K, const bf16* VT, bf16* O, int gw, int NGW, int lane) {
    constexpr int NQB = (L + 31) / 32;
    const int ql = lane & 31, hi = lane >> 5;
    const int UPW = (128 * (NQB - 1) + NGW - 1) / NGW;
    for (int it = 0; it <= UPW; ++it) {
        int bh, qb;
        if (it < UPW) { const int w2 = gw * UPW + it; if (w2 >= 128 * (NQB - 1)) continue; bh = w2 / (NQB - 1); qb = w2 - bh * (NQB - 1) + 1; }
        else { if (gw >= 128) break; bh = gw; qb = 0; }
        const int tq = 32 * qb + ql; const bool valid = tq < L; const int tqc = valid ? tq : L - 1;
        const bf16* Qb = Q + (size_t)bh * L * 64; const bf16* Kb = K + (size_t)bh * L * 64; const bf16* Vb = VT + (size_t)bh * 65 * 2048;
        bf16x8_t qf[4];
#pragma unroll
        for (int t = 0; t < 4; ++t) qf[t] = *(const bf16x8_t*)(Qb + (size_t)tqc * 64 + 16 * t + 8 * hi);
        f32x16 o0, o1;
#pragma unroll
        for (int r = 0; r < 16; ++r) { o0[r] = 0.f; o1[r] = 0.f; }
        float surv = 1.0f;
        bf16x8_t kn[4]; v2u vn[2][2][2];
#define SB_LOAD(kt_) do { const bf16* kp_ = Kb + (size_t)(32 * (kt_) + ql) * 64 + 8 * hi; \
        _Pragma("unroll") for (int t = 0; t < 4; ++t) kn[t] = *(const bf16x8_t*)(kp_ + 16 * t); \
        _Pragma("unroll") for (int mb = 0; mb < 2; ++mb) { const v4u* vp_ = (const v4u*)(Vb + ((size_t)(kt_) * 2 + mb) * 1024 + lane * 16); const v4u x0 = vp_[0], x1 = vp_[1]; \
            vn[mb][0][0] = (v2u){x0.x, x0.y}; vn[mb][0][1] = (v2u){x0.z, x0.w}; vn[mb][1][0] = (v2u){x1.x, x1.y}; vn[mb][1][1] = (v2u){x1.z, x1.w}; } \
        if (32 * (kt_) + 16 >= L) { vn[0][1][0] = (v2u){0u, 0u}; vn[0][1][1] = (v2u){0u, 0u}; vn[1][1][0] = (v2u){0u, 0u}; vn[1][1][1] = (v2u){0u, 0u}; } } while (0)
        bf16x8_t km[4]; v2u vm[2][2][2];
        SB_LOAD(qb);
#define SB_SHIFT(KD, VD, KS, VS) do { _Pragma("unroll") for (int t = 0; t < 4; ++t) KD[t] = KS[t]; \
        _Pragma("unroll") for (int mb = 0; mb < 2; ++mb) _Pragma("unroll") for (int s = 0; s < 2; ++s) { VD[mb][s][0] = VS[mb][s][0]; VD[mb][s][1] = VS[mb][s][1]; } } while (0)
        SB_SHIFT(km, vm, kn, vn);
        if (qb > 0) SB_LOAD(qb - 1);
        for (int kt = qb; kt >= 0; --kt) {
            bf16x8_t kf[4]; v2u vf[2][2][2];
            SB_SHIFT(kf, vf, km, vm);
            SB_SHIFT(km, vm, kn, vn);
            if (kt > 1) SB_LOAD(kt - 2);
            f32x16 S;
#pragma unroll
            for (int r = 0; r < 16; ++r) S[r] = 0.f;
#pragma unroll
            for (int t = 0; t < 4; ++t) S = __builtin_amdgcn_mfma_f32_32x32x16_bf16(kf[t], qf[t], S, 0, 0, 0);
            const bool diag = (kt == qb);
            float om[16], be[16], w[16];
#pragma unroll
            for (int r = 0; r < 16; ++r) {
                const float z = S[r] * 0.125f; const int kl = 8 * (r >> 2) + 4 * hi + (r & 3);
                const bool vis = !diag || kl < ql;
                const float t = __expf(-fmaxf(z, -80.0f));
                const float b = __builtin_amdgcn_rcpf(1.0f + t);
                be[r] = vis ? b : 0.f; om[r] = vis ? t * b : 1.0f;
            }
            float gp = 1.0f;
#pragma unroll
            for (int g = 3; g >= 0; --g) {
                const float T = (om[4 * g] * om[4 * g + 1]) * (om[4 * g + 2] * om[4 * g + 3]);
                const float U = __shfl_xor(T, 32);
                const float a3 = surv * gp * (hi == 0 ? U : 1.0f), a2 = a3 * om[4 * g + 3], a1 = a2 * om[4 * g + 2], a0 = a1 * om[4 * g + 1];
                w[4 * g + 3] = be[4 * g + 3] * a3; w[4 * g + 2] = be[4 * g + 2] * a2; w[4 * g + 1] = be[4 * g + 1] * a1; w[4 * g] = be[4 * g] * a0;
                gp *= T * U;
            }
            surv *= gp;
#pragma unroll
            for (int s = 0; s < 2; ++s) {
                v4u pw; pw.x = pk2(w[8 * s], w[8 * s + 1]); pw.y = pk2(w[8 * s + 2], w[8 * s + 3]); pw.z = pk2(w[8 * s + 4], w[8 * s + 5]); pw.w = pk2(w[8 * s + 6], w[8 * s + 7]);
                const bf16x8_t wb = __builtin_bit_cast(bf16x8_t, pw);
                v4u a0v; a0v.x = vf[0][s][0].x; a0v.y = vf[0][s][0].y; a0v.z = vf[0][s][1].x; a0v.w = vf[0][s][1].y;
                v4u a1v; a1v.x = vf[1][s][0].x; a1v.y = vf[1][s][0].y; a1v.z = vf[1][s][1].x; a1v.w = vf[1][s][1].y;
                o0 = __builtin_amdgcn_mfma_f32_32x32x16_bf16(__builtin_bit_cast(bf16x8_t, a0v), wb, o0, 0, 0, 0);
                o1 = __builtin_amdgcn_mfma_f32_32x32x16_bf16(__builtin_bit_cast(bf16x8_t, a1v), wb, o1, 0, 0, 0);
            }
            if (__ballot(valid && surv >= 1.17549435e-38f) == 0ull) break;
        }
#undef SB_LOAD
#undef SB_SHIFT
        if (valid) {
            const int b = bh >> 4, h = bh & 15;
            bf16* op = O + ((size_t)b * L + tq) * D + h * 64 + 4 * hi;
#pragma unroll
            for (int g = 0; g < 4; ++g) {
                v2u w0; w0.x = pk2(o0[4 * g], o0[4 * g + 1]); w0.y = pk2(o0[4 * g + 2], o0[4 * g + 3]); *(v2u*)(op + 8 * g) = w0;
                v2u w1; w1.x = pk2(o1[4 * g], o1[4 * g + 1]); w1.y = pk2(o1[4 * g + 2], o1[4 * g + 3]); *(v2u*)(op + 32 + 8 * g) = w1;
            }
        }
    }
}

#ifndef GLA_CHUNKED
#define GLA_CHUNKED 1
#endif
__device__ __forceinline__ void gla_decay_phase(const float* GL, const float* Wg, const float* bg, float* A, int tid, int G) {
    const int k = tid; float wg[16];
#pragma unroll
    for (int j = 0; j < 16; ++j) wg[j] = Wg[j * 512 + k];
    const float bk = bg[k];
    for (int row0 = blockIdx.x * 4; row0 < M; row0 += G * 4) {
        f32x4 g[4][4];
#pragma unroll
        for (int u = 0; u < 4; ++u)
#pragma unroll
            for (int q = 0; q < 4; ++q) g[u][q] = *(const f32x4*)(GL + (size_t)(row0 + u) * 16 + 4 * q);
#pragma unroll
        for (int u = 0; u < 4; ++u) {
            float x = bk;
#pragma unroll
            for (int q = 0; q < 4; ++q) x += (g[u][q][0] * wg[4 * q] + g[u][q][1] * wg[4 * q + 1]) + (g[u][q][2] * wg[4 * q + 2] + g[u][q][3] * wg[4 * q + 3]);
            const float ls = fminf(x, 0.f) - __logf(1.0f + __expf(-fabsf(x)));
            A[(size_t)(row0 + u) * 512 + k] = GLA_CHUNKED ? ls * (1.0f / 16.0f) : __expf(ls * (1.0f / 16.0f));
        }
    }
}

__device__ __forceinline__ void gla_scan_phase(const bf16* P, const float* A, float* OG, LAS unsigned char* lds, int tid, int wave, int lane, int G) {
    LAS unsigned char* la = lds; LAS unsigned char* lk = lds + 32768; LAS unsigned char* lq = lds + 49152; LAS unsigned char* lv = lds + 65536; LAS float* lo = (LAS float*)(lds + 69632);
    const int ks = lane >> 2, vi = lane & 3, vcol = 4 * wave + vi;
    for (int unit = blockIdx.x; unit < 256; unit += G) {
        const int b = unit >> 5, h = (unit >> 3) & 3, vq = unit & 7;
        float S[8];
#pragma unroll
        for (int j = 0; j < 8; ++j) S[j] = 0.f;
        v4u ra[4], rk[2], rq[2], rv;
        const int NCH = (L + 63) / 64;
#define GLA_LOAD(c) do { const int n_ = min(64, L - 64 * (c)); const size_t m0_ = (size_t)b * L + 64 * (c); \
        _Pragma("unroll") for (int i = 0; i < 4; ++i) { const int p = tid + 512 * i, r = p >> 5, cc = p & 31; ra[i] = r < n_ ? *(const v4u*)(A + (m0_ + r) * 512 + 128 * h + 4 * cc) : (v4u){0u, 0u, 0u, 0u}; } \
        _Pragma("unroll") for (int i = 0; i < 2; ++i) { const int p = tid + 512 * i, r = p >> 4, cc = p & 15; \
            rk[i] = r < n_ ? *(const v4u*)(P + (m0_ + r) * 3072 + 512 + 128 * h + 8 * cc) : (v4u){0u, 0u, 0u, 0u}; rq[i] = r < n_ ? *(const v4u*)(P + (m0_ + r) * 3072 + 128 * h + 8 * cc) : (v4u){0u, 0u, 0u, 0u}; } \
        { const int r = tid >> 2, cc = tid & 3; rv = (tid < 256 && r < n_) ? *(const v4u*)(P + (m0_ + r) * 3072 + 1024 + 256 * h + 32 * vq + 8 * cc) : (v4u){0u, 0u, 0u, 0u}; } } while (0)
        GLA_LOAD(0);
        for (int c = 0; c < NCH; ++c) {
            const int n = min(64, L - 64 * c);
#pragma unroll
            for (int i = 0; i < 4; ++i) { const int p = tid + 512 * i; *(LAS v4u*)(la + p * 16) = ra[i]; }
#pragma unroll
            for (int i = 0; i < 2; ++i) { const int p = tid + 512 * i; *(LAS v4u*)(lk + p * 16) = rk[i]; *(LAS v4u*)(lq + p * 16) = rq[i]; }
            if (tid < 256) *(LAS v4u*)(lv + tid * 16) = rv;
            __syncthreads();
            if (c + 1 < NCH) GLA_LOAD(c + 1);
            for (int tt0 = 0; tt0 < n; tt0 += 4) {
                float ov[4];
#pragma unroll
                for (int u = 0; u < 4; ++u) {
                    const int tt = tt0 + u;
                    const f32x4 a0 = *(const LAS f32x4*)(la + tt * 512 + ks * 32), a1 = *(const LAS f32x4*)(la + tt * 512 + ks * 32 + 16);
                    const v4u kr = *(const LAS v4u*)(lk + tt * 256 + ks * 16), qr = *(const LAS v4u*)(lq + tt * 256 + ks * 16);
                    const float vv = __builtin_bit_cast(float, (unsigned)(*(const LAS unsigned short*)(lv + tt * 64 + vcol * 2)) << 16);
                    float o, o2;
                    S[0] = S[0] * a0[0] + bflo(kr.x) * vv; o  = bflo(qr.x) * S[0];
                    S[1] = S[1] * a0[1] + bfhi(kr.x) * vv; o2 = bfhi(qr.x) * S[1];
                    S[2] = S[2] * a0[2] + bflo(kr.y) * vv; o  += bflo(qr.y) * S[2];
                    S[3] = S[3] * a0[3] + bfhi(kr.y) * vv; o2 += bfhi(qr.y) * S[3];
                    S[4] = S[4] * a1[0] + bflo(kr.z) * vv; o  += bflo(qr.z) * S[4];
                    S[5] = S[5] * a1[1] + bfhi(kr.z) * vv; o2 += bfhi(qr.z) * S[5];
                    S[6] = S[6] * a1[2] + bflo(kr.w) * vv; o  += bflo(qr.w) * S[6];
                    S[7] = S[7] * a1[3] + bfhi(kr.w) * vv; o2 += bfhi(qr.w) * S[7];
                    ov[u] = o + o2;
                }
#pragma unroll
                for (int u = 0; u < 4; ++u) {
                    const int x = __builtin_bit_cast(int, ov[u]);
                    const float r4 = __builtin_bit_cast(float, __builtin_amdgcn_update_dpp(0, x, 0x124, 0xf, 0xf, false));
                    const float r8 = __builtin_bit_cast(float, __builtin_amdgcn_update_dpp(0, x, 0x128, 0xf, 0xf, false));
                    const float r12 = __builtin_bit_cast(float, __builtin_amdgcn_update_dpp(0, x, 0x12C, 0xf, 0xf, false));
                    ov[u] = (ov[u] + r4) + (r8 + r12);
                }
                if ((lane & 12) == 0) {
#pragma unroll
                    for (int u = 0; u < 4; ++u) lo[((tt0 + u) * 4 + (lane >> 4)) * 32 + vcol] = ov[u] * 0.08838834764831845f;
                }
            }
            __syncthreads();
            const size_t m0 = (size_t)b * L + 64 * c;
#pragma unroll
            for (int i = 0; i < 4; ++i) { const int idx = tid + 512 * i, r = idx >> 5, cc = idx & 31; if (r < n) OG[(m0 + r) * 1024 + 256 * h + 32 * vq + cc] = (lo[(r * 4 + 0) * 32 + cc] + lo[(r * 4 + 1) * 32 + cc]) + (lo[(r * 4 + 2) * 32 + cc] + lo[(r * 4 + 3) * 32 + cc]); }
        }
#undef GLA_LOAD
        __syncthreads();
    }
}


constexpr int GLA_NCH = 33, GLA_UNITS = NB * GLA_NCH * 4;
constexpr size_t WS_GQD = 244 * MiB, WS_GKST = 3 * MiB, WS_GATT = 376 * MiB, WS_GDEC = 385 * MiB, WS_GVT = 343 * MiB;
__device__ __forceinline__ void gla_pre_phase(const bf16* P, const float* GL, const float* Wg, const float* bg, bf16* QDP, bf16* KST, bf16* ATT, bf16* VT2, float* DEC, LAS unsigned char* lds, int tid, int wave, int lane, int G) {
    LAS float* Bm = (LAS float*)lds;
    LAS unsigned short* QDl = (LAS unsigned short*)(lds + 32768);
    LAS unsigned short* KDl = (LAS unsigned short*)(lds + 49152);
    LAS unsigned short* KSl = (LAS unsigned short*)(lds + 65536);
    LAS unsigned short* VTl = (LAS unsigned short*)(lds + 81920);
    LAS float* TOT = (LAS float*)(lds + 114688);
    LAS float* GLs = (LAS float*)(lds + 116736);
    for (int u = blockIdx.x; u < GLA_UNITS; u += G) {
        const int h = u & 3, bn = u >> 2, n = bn % GLA_NCH, b = bn / GLA_NCH;
        const int t0 = 64 * n - 48;
        v4u pq0 = (v4u){0u, 0u, 0u, 0u}, pq1 = pq0, pk0 = pq0, pk1 = pq0;
        { const int t = t0 + (tid >> 3); if (t >= 0) { const bf16* pr = P + ((size_t)b * L + t) * 3072 + 128 * h + 16 * (tid & 7); pq0 = *(const v4u*)pr; pq1 = *(const v4u*)(pr + 8); pk0 = *(const v4u*)(pr + 512); pk1 = *(const v4u*)(pr + 520); } }
#pragma unroll
        for (int i = 0; i < 4; ++i) {
            const int p = tid + 512 * i, r = p >> 5, cc = p & 31, t = t0 + r;
            v4u vv = (v4u){0u, 0u, 0u, 0u};
            if (t >= 0) vv = *(const v4u*)(P + ((size_t)b * L + t) * 3072 + 1024 + 256 * h + 8 * cc);
            LAS unsigned short* vp = VTl + (8 * cc) * 64 + (r ^ (8 * (cc & 7)));
            vp[0] = (unsigned short)(vv.x & 0xffffu); vp[64] = (unsigned short)(vv.x >> 16); vp[128] = (unsigned short)(vv.y & 0xffffu); vp[192] = (unsigned short)(vv.y >> 16);
            vp[256] = (unsigned short)(vv.z & 0xffffu); vp[320] = (unsigned short)(vv.z >> 16); vp[384] = (unsigned short)(vv.w & 0xffffu); vp[448] = (unsigned short)(vv.w >> 16);
        }
        if (tid < 256) { const int r = tid >> 2, cc = tid & 3, t = t0 + r;
            *(LAS f32x4*)(GLs + r * 16 + 4 * cc) = t >= 0 ? *(const f32x4*)(GL + ((size_t)b * L + t) * 16 + 4 * cc) : (f32x4){0.f, 0.f, 0.f, 0.f}; }
        __syncthreads();
        { const int k = tid & 127, seg = tid >> 7; float run = 0.f;
          float wg[16];
#pragma unroll
          for (int j2 = 0; j2 < 16; ++j2) wg[j2] = Wg[j2 * 512 + 128 * h + k];
          const float bk = bg[128 * h + k];
#pragma unroll 4
          for (int i = 0; i < 16; ++i) {
              const int row = 16 * seg + i; const LAS f32x4* gr = (const LAS f32x4*)(GLs + row * 16);
              const f32x4 g0 = gr[0], g1 = gr[1], g2 = gr[2], g3 = gr[3];
              float x = bk + (g0[0] * wg[0] + g0[1] * wg[1]) + (g0[2] * wg[2] + g0[3] * wg[3]) + (g1[0] * wg[4] + g1[1] * wg[5]) + (g1[2] * wg[6] + g1[3] * wg[7])
                           + (g2[0] * wg[8] + g2[1] * wg[9]) + (g2[2] * wg[10] + g2[3] * wg[11]) + (g3[0] * wg[12] + g3[1] * wg[13]) + (g3[2] * wg[14] + g3[3] * wg[15]);
              const float ls = fminf(x, 0.f) - __logf(1.0f + __expf(-fabsf(x)));
              run += (t0 + row >= 0) ? ls * (1.0f / 16.0f) : 0.f; Bm[row * 128 + k] = run;
          }
          TOT[seg * 128 + k] = run; }
        __syncthreads();
        { const int k = tid & 127, seg = tid >> 7; float pre = 0.f;
          for (int s = 0; s < seg; ++s) pre += TOT[s * 128 + k];
          if (seg) {
#pragma unroll
              for (int i = 0; i < 16; ++i) Bm[(16 * seg + i) * 128 + k] += pre; } }
        __syncthreads();
        { const int c = tid >> 3, sg = tid & 7, t = t0 + c;
          const v4u q0 = pq0, q1 = pq1, k0 = pk0, k1 = pk1;
          const unsigned qw[8] = {q0.x, q0.y, q0.z, q0.w, q1.x, q1.y, q1.z, q1.w}, kw[8] = {k0.x, k0.y, k0.z, k0.w, k1.x, k1.y, k1.z, k1.w};
          float qd[16], kd[16];
#pragma unroll
          for (int e = 0; e < 16; ++e) {
              const float bb = Bm[c * 128 + 16 * sg + e], bl = Bm[63 * 128 + 16 * sg + e];
              const float qv = (e & 1) ? bfhi(qw[e >> 1]) : bflo(qw[e >> 1]), kv = (e & 1) ? bfhi(kw[e >> 1]) : bflo(kw[e >> 1]);
              qd[e] = qv * 0.08838834764831845f * __expf(bb); kd[e] = kv * __expf(-bb);
              KSl[(16 * sg + e) * 64 + (c ^ (8 * sg))] = (unsigned short)f2bf(kv * __expf(bl - bb));
          }
          v4u a0, a1, b0, b1;
          a0.x = pk2(qd[0], qd[1]); a0.y = pk2(qd[2], qd[3]); a0.z = pk2(qd[8], qd[9]); a0.w = pk2(qd[10], qd[11]);
          a1.x = pk2(qd[4], qd[5]); a1.y = pk2(qd[6], qd[7]); a1.z = pk2(qd[12], qd[13]); a1.w = pk2(qd[14], qd[15]);
          b0.x = pk2(kd[0], kd[1]); b0.y = pk2(kd[2], kd[3]); b0.z = pk2(kd[8], kd[9]); b0.w = pk2(kd[10], kd[11]);
          b1.x = pk2(kd[4], kd[5]); b1.y = pk2(kd[6], kd[7]); b1.z = pk2(kd[12], kd[13]); b1.w = pk2(kd[14], kd[15]);
          *(LAS v4u*)(QDl + c * 128 + 16 * sg) = a0; *(LAS v4u*)(QDl + c * 128 + 16 * sg + 8) = a1;
          *(LAS v4u*)(KDl + c * 128 + 16 * sg) = b0; *(LAS v4u*)(KDl + c * 128 + 16 * sg + 8) = b1;
          bf16* gq = QDP + (size_t)u * 8192 + c * 128 + 16 * sg; *(v4u*)gq = a0; *(v4u*)(gq + 8) = a1;
        }
        if (tid < 128) DEC[(size_t)u * 128 + tid] = __expf(Bm[63 * 128 + tid]);
        __syncthreads();
        if (wave < 4) {
            const int mb = wave >> 1, nb = wave & 1, ql = lane & 31, hi = lane >> 5;
            f32x16 acc;
#pragma unroll
            for (int r = 0; r < 16; ++r) acc[r] = 0.f;
#pragma unroll
            for (int st = 0; st < 8; ++st) {
                const bf16x8_t a = *(const LAS bf16x8_t*)(QDl + (32 * mb + ql) * 128 + 16 * st + 8 * hi), bq = *(const LAS bf16x8_t*)(KDl + (32 * nb + ql) * 128 + 16 * st + 8 * hi);
                acc = __builtin_amdgcn_mfma_f32_32x32x16_bf16(a, bq, acc, 0, 0, 0);
            }
            bf16* ap = ATT + (size_t)u * 4096 + 32 * nb + ql;
#pragma unroll
            for (int r = 0; r < 16; ++r) { const int c = 32 * mb + 8 * (r >> 2) + 4 * hi + (r & 3), s = 32 * nb + ql; ap[c * 64] = (bf16)f2bf(s <= c ? acc[r] : 0.f); }
        }
#pragma unroll
        for (int i = 0; i < 2; ++i) { const int p = tid + 512 * i, kk = p >> 3, ch = p & 7; *(v4u*)(KST + (size_t)u * 8192 + p * 8) = *(const LAS v4u*)(KSl + kk * 64 + 8 * (ch ^ ((kk >> 4) & 7))); }
#pragma unroll
        for (int i = 0; i < 4; ++i) { const int p = tid + 512 * i, vv2 = p >> 3, ch = p & 7; *(v4u*)(VT2 + (size_t)u * 16384 + p * 8) = *(const LAS v4u*)(VTl + vv2 * 64 + 8 * (ch ^ ((vv2 >> 3) & 7))); }
        __syncthreads();
    }
}

__device__ __forceinline__ bf16x8_t gla_pack(const f32x16& x, int half) {
    v4u p; p.x = pk2(x[8 * half], x[8 * half + 1]); p.y = pk2(x[8 * half + 2], x[8 * half + 3]); p.z = pk2(x[8 * half + 4], x[8 * half + 5]); p.w = pk2(x[8 * half + 6], x[8 * half + 7]);
    return __builtin_bit_cast(bf16x8_t, p);
}
__device__ __forceinline__ void gla_seq_phase(const bf16* QDP, const bf16* KST, const bf16* ATT, const bf16* VT2, const float* DEC, float* OG, LAS unsigned char* lds, int tid, int wave, int lane, int G) {
    volatile LAS unsigned* flags = (volatile LAS unsigned*)(lds + 16384);
    if (tid < 4) flags[tid] = 0u;
    __syncthreads();
    const int unit = blockIdx.x;
    if (wave >= 3 || unit >= 256) return;
    const int ql = lane & 31, hi = lane >> 5;
    const int xcd = unit & 7, idx = unit >> 3, bhx = xcd * 4 + (idx >> 3);
    const int b = bhx >> 2, h = bhx & 3, vs = idx & 7;
    const size_t u0 = (size_t)(b * GLA_NCH) * 4 + h;
    const bf16* vtb = VT2 + u0 * 16384 + (size_t)(32 * vs + ql) * 64 + 8 * hi;
#define GLA_SPIN(cond) do { unsigned sp_ = 0; while ((cond) && ++sp_ < (1u << 22)) __builtin_amdgcn_s_sleep(1); } while (0)
    if (wave == 0) {
        const bf16* ksb = KST + u0 * 8192 + ql * 64 + 8 * hi; const float* decb = DEC + u0 * 128 + 4 * hi;
        f32x16 S0, S1, S2, S3;
#pragma unroll
        for (int r = 0; r < 16; ++r) { S0[r] = 0.f; S1[r] = 0.f; S2[r] = 0.f; S3[r] = 0.f; }
        bf16x8_t vf[4], k0[4], k1[4], k2[4], k3[4]; f32x4 d0[4], d1[4], d2[4], d3[4];
#pragma unroll
        for (int st = 0; st < 4; ++st) { vf[st] = *(const bf16x8_t*)(vtb + 16 * st); k0[st] = *(const bf16x8_t*)(ksb + 16 * st); k1[st] = *(const bf16x8_t*)(ksb + 2048 + 16 * st);
            k2[st] = *(const bf16x8_t*)(ksb + 4096 + 16 * st); k3[st] = *(const bf16x8_t*)(ksb + 6144 + 16 * st);
            d0[st] = *(const f32x4*)(decb + 8 * st); d1[st] = *(const f32x4*)(decb + 32 + 8 * st); d2[st] = *(const f32x4*)(decb + 64 + 8 * st); d3[st] = *(const f32x4*)(decb + 96 + 8 * st); }
        for (int n = 0; n < GLA_NCH; ++n) {
            if (n >= 2) { GLA_SPIN(flags[1] < (unsigned)(n - 1) || flags[2] < (unsigned)(n - 1)); }
            LAS unsigned char* slot = lds + (n & 1) * 8192 + lane * 16;
            *(LAS bf16x8_t*)(slot + 0 * 1024) = gla_pack(S0, 0); *(LAS bf16x8_t*)(slot + 1 * 1024) = gla_pack(S0, 1); *(LAS bf16x8_t*)(slot + 2 * 1024) = gla_pack(S1, 0); *(LAS bf16x8_t*)(slot + 3 * 1024) = gla_pack(S1, 1);
            *(LAS bf16x8_t*)(slot + 4 * 1024) = gla_pack(S2, 0); *(LAS bf16x8_t*)(slot + 5 * 1024) = gla_pack(S2, 1); *(LAS bf16x8_t*)(slot + 6 * 1024) = gla_pack(S3, 0); *(LAS bf16x8_t*)(slot + 7 * 1024) = gla_pack(S3, 1);
            __builtin_amdgcn_fence(__ATOMIC_RELEASE, "workgroup");
            if (lane == 0) flags[0] = (unsigned)(n + 1);
            const int nn = n + 1 < GLA_NCH ? n + 1 : n;
            const bf16* ksn = ksb + (size_t)nn * 4 * 8192; const float* decn = decb + (size_t)nn * 4 * 128; const bf16* vtn = vtb + (size_t)nn * 4 * 16384;
#define GLA_SUPD(SX, KX, DX, kb) do { _Pragma("unroll") for (int g = 0; g < 4; ++g) { SX[4 * g] *= DX[g][0]; SX[4 * g + 1] *= DX[g][1]; SX[4 * g + 2] *= DX[g][2]; SX[4 * g + 3] *= DX[g][3]; } \
                _Pragma("unroll") for (int g = 0; g < 4; ++g) DX[g] = *(const f32x4*)(decn + 32 * (kb) + 8 * g); \
                _Pragma("unroll") for (int st = 0; st < 4; ++st) SX = __builtin_amdgcn_mfma_f32_32x32x16_bf16(KX[st], vf[st], SX, 0, 0, 0); \
                _Pragma("unroll") for (int st = 0; st < 4; ++st) KX[st] = *(const bf16x8_t*)(ksn + (kb) * 2048 + 16 * st); } while (0)
            GLA_SUPD(S0, k0, d0, 0); GLA_SUPD(S1, k1, d1, 1); GLA_SUPD(S2, k2, d2, 2); GLA_SUPD(S3, k3, d3, 3);
#undef GLA_SUPD
#pragma unroll
            for (int st = 0; st < 4; ++st) vf[st] = *(const bf16x8_t*)(vtn + 16 * st);
        }
    } else {
        const int mb = wave - 1;
        const bf16* attb = ATT + u0 * 4096 + (size_t)(32 * mb + ql) * 64 + 8 * hi; const bf16* qdb = QDP + u0 * 8192 + (size_t)(32 * mb + ql) * 128 + 8 * hi;
        bf16x8_t vf[4], af[4], qf[8];
#pragma unroll
        for (int st = 0; st < 4; ++st) { vf[st] = *(const bf16x8_t*)(vtb + 16 * st); af[st] = *(const bf16x8_t*)(attb + 16 * st); }
#pragma unroll
        for (int st = 0; st < 8; ++st) qf[st] = *(const bf16x8_t*)(qdb + 16 * st);
        for (int n = 0; n < GLA_NCH; ++n) {
            const int nn = n + 1 < GLA_NCH ? n + 1 : n;
            f32x16 o;
#pragma unroll
            for (int r = 0; r < 16; ++r) o[r] = 0.f;
#pragma unroll
            for (int st = 0; st < 4; ++st) o = __builtin_amdgcn_mfma_f32_32x32x16_bf16(af[st], vf[st], o, 0, 0, 0);
#pragma unroll
            for (int st = 0; st < 4; ++st) { af[st] = *(const bf16x8_t*)(attb + (size_t)nn * 4 * 4096 + 16 * st); vf[st] = *(const bf16x8_t*)(vtb + (size_t)nn * 4 * 16384 + 16 * st); }
            GLA_SPIN(flags[0] < (unsigned)(n + 1));
            __builtin_amdgcn_fence(__ATOMIC_ACQUIRE, "workgroup");
            const LAS unsigned char* slot = lds + (n & 1) * 8192 + lane * 16;
            bf16x8_t sb[8];
#pragma unroll
            for (int st = 0; st < 8; ++st) sb[st] = *(const LAS bf16x8_t*)(slot + st * 1024);
            asm volatile("s_waitcnt lgkmcnt(0)" ::: "memory");
            if (lane == 0) flags[wave] = (unsigned)(n + 1);
            f32x16 o2;
#pragma unroll
            for (int r = 0; r < 16; ++r) o2[r] = 0.f;
#pragma unroll
            for (int st = 0; st < 8; st += 2) { o = __builtin_amdgcn_mfma_f32_32x32x16_bf16(qf[st], sb[st], o, 0, 0, 0); o2 = __builtin_amdgcn_mfma_f32_32x32x16_bf16(qf[st + 1], sb[st + 1], o2, 0, 0, 0); }
#pragma unroll
            for (int r = 0; r < 16; ++r) o[r] += o2[r];
#pragma unroll
            for (int st = 0; st < 8; ++st) qf[st] = *(const bf16x8_t*)(qdb + (size_t)nn * 4 * 8192 + 16 * st);
#pragma unroll
            for (int r = 0; r < 16; ++r) { const int t = 64 * n - 48 + 32 * mb + 8 * (r >> 2) + 4 * hi + (r & 3); if (t >= 0) OG[((size_t)b * L + t) * 1024 + 256 * h + 32 * vs + ql] = o[r]; }
        }
    }
#undef GLA_SPIN
}

__device__ __forceinline__ void gla_gate_phase(const float* OG, const bf16* P, const float* gout, bf16* GA, int gw, int NGW, int lane) {
    for (int row = gw; row < M; row += NGW) {
#pragma unroll
        for (int j = 0; j < 4; ++j) {
            const f32x4 o = *((const f32x4*)(OG + (size_t)row * 1024 + 256 * j) + lane);
            const float ss = wave_sum((o[0] * o[0] + o[1] * o[1]) + (o[2] * o[2] + o[3] * o[3]));
            const float r = __builtin_amdgcn_rsqf(ss * (1.0f / 256.0f) + 1e-6f);
            const f32x4 g = *((const f32x4*)(gout + 256 * j) + lane);
            const v2u rr = *((const v2u*)(P + (size_t)row * 3072 + 2048 + 256 * j) + lane);
            const float r0 = bflo(rr.x), r1 = bfhi(rr.x), r2 = bflo(rr.y), r3 = bfhi(rr.y);
            const float y0 = o[0] * r * g[0] * pg8::silu_f(r0), y1 = o[1] * r * g[1] * pg8::silu_f(r1), y2 = o[2] * r * g[2] * pg8::silu_f(r2), y3 = o[3] * r * g[3] * pg8::silu_f(r3);
            v2u w; w.x = pk2(y0, y1); w.y = pk2(y2, y3);
            *((v2u*)(GA + (size_t)row * 1024 + 256 * j) + lane) = w;
        }
    }
}

template <class Epi> __device__ __forceinline__ void run_gemm(LAS unsigned char* lds, const bf16* A, const bf16* Bt, int N, int K, const Epi& E, int G) {
    pg8::Gemm g{A, Bt, MP, N, K}; pg8::StaticOrder S; S.init(MP, N, G, (int)blockIdx.x, K / 64);
    pg8::gemm_phase<Epi, pg8::StaticOrder, true, true>((PG8_LAS unsigned char*)lds, g, S, E);
}
template <class Epi> __device__ __forceinline__ void run_gemm_split(LAS unsigned char* lds, const bf16* A, const bf16* Bt, int K, int nsplit, const Epi& E, int G) {
    pg8::Gemm g{A, Bt, MP, 1024, K}; pg8::SplitTailOrder S; S.init(G, (int)blockIdx.x, K / 64, nsplit);
    pg8::gemm_phase<Epi, pg8::SplitTailOrder, true, true>((PG8_LAS unsigned char*)lds, g, S, E);
}
template <bool FINAL> __device__ __forceinline__ void tail_finalize(const float* SLAB, int nsplit, float* Hp, bf16* HBp, float* SSp, float* OUT, float wres, int gw, int lane) {
    if (gw >= M - 64 * 256) return;
    const int row = 64 * 256 + gw;
    f32x4 a[4];
#pragma unroll
    for (int j = 0; j < 4; ++j) a[j] = (f32x4){0.f, 0.f, 0.f, 0.f};
    for (int s = 0; s < nsplit; ++s)
#pragma unroll
        for (int j = 0; j < 4; ++j) a[j] += *((const f32x4*)(SLAB + ((size_t)s * 256 + gw) * 1024 + 256 * j) + lane);
    float ss = 0.f;
    const int bb = row / L, tt = row - bb * L;
#pragma unroll
    for (int j = 0; j < 4; ++j) {
        v2u* hbp = (v2u*)(HBp + (size_t)row * D + 256 * j) + lane;
        const v2u hw = *hbp;
        const f32x4 hv = (f32x4){bflo(hw.x), bfhi(hw.x), bflo(hw.y), bfhi(hw.y)};
        const f32x4 v = hv + a[j] * wres;
        if (FINAL) { if (tt >= NMETA) *((f32x4*)(OUT + ((size_t)bb * SEQ + (tt - NMETA)) * D + 256 * j) + lane) = v; }
        else { v2u w; w.x = pk2(v[0], v[1]); w.y = pk2(v[2], v[3]); *hbp = w;
               const float r0 = bflo(w.x), r1 = bfhi(w.x), r2 = bflo(w.y), r3 = bfhi(w.y); ss += (r0 * r0 + r1 * r1) + (r2 * r2 + r3 * r3); }
    }
    if (!FINAL) { ss = wave_sum(ss); if (lane < 16) SSp[(size_t)row * 16 + lane] = lane == 0 ? ss : 0.f; }
}

#ifndef SB_NAIVE
#define SB_ATTN_FN sb_attn_mfma
#define SB_VT_PITCH SB_LP
#else
#define SB_ATTN_FN sb_attn_phase
#define SB_VT_PITCH 0
#endif
#ifndef REP_SB
#define REP_SB 1
#endif
#ifndef REP_GU
#define REP_GU 1
#endif
#ifndef REP_MIX
#define REP_MIX 1
#endif
#ifndef REP_DOWN
#define REP_DOWN 1
#endif
#ifndef REP_OUT
#define REP_OUT 1
#endif
#ifndef REP_PRE
#define REP_PRE 1
#endif
#ifndef REP_CONV
#define REP_CONV 1
#endif
#ifndef REP_GATE
#define REP_GATE 1
#endif
#ifndef REP_SCAN
#define REP_SCAN 1
#endif
#ifndef REP_SYNC
#define REP_SYNC 0
#endif
__global__ void __launch_bounds__(NTHR, 2) fwd_megakernel(Args args) {
    extern __shared__ __attribute__((aligned(16))) unsigned char lds_raw[];
    LAS unsigned char* lds = (LAS unsigned char*)lds_raw;
    cg::grid_group grid = cg::this_grid();
    volatile LAS unsigned* MISC = (volatile LAS unsigned*)(lds + 131072 + 320);
    if (threadIdx.x < 32) MISC[threadIdx.x] = 0u;
    __syncthreads();
    if (blockIdx.x == 0) { unsigned* ctl = (unsigned*)(KWS + WS_CTL); for (int i = threadIdx.x; i < XCD_BAR_WORDS; i += NTHR) ctl[CW_BAR + i] = 0u; if (threadIdx.x < 128) ctl[CW_CNT + threadIdx.x] = 0u; }
    XcdBarrier bar; bar.bar = (unsigned*)(KWS + WS_CTL) + CW_BAR; bar.x = 0; bar.st = MISC + 8;
#ifdef USE_CG_SYNC
#define GRID_BAR() grid.sync()
#else
#define GRID_BAR() xcd_barrier(bar)
#endif
    const int wave = __builtin_amdgcn_readfirstlane(threadIdx.x >> 6);
    const int G = gridDim.x, gw = blockIdx.x * NWAVES + wave, NGW = G * NWAVES, GT = G * NTHR;
#define FRESH_TID() ({ int t_ = threadIdx.x; asm volatile("" : "+v"(t_)); t_; })
#define ws KWS
#define H ((float*)(ws + WS_H))
#define HB ((bf16*)(ws + WS_HB))
#define SS ((float*)(ws + WS_SS))
#define ACT ((bf16*)(ws + WS_ACT))

#define RES_GEMM(FIN, Aptr, Wptr, KK, NS, WR, GI) do { \
        pg8::EpiRes E{H, HB, SS, KOUT, WR, (float*)(ws + WS_SLAB), (unsigned*)(ws + WS_CTL) + CW_CNT + 4 * (GI), lds + 131072 + 1024, FIN, NS}; run_gemm_split(lds, Aptr, Wptr, KK, NS, E, G); } while (0)
    { const int tid = FRESH_TID(); prologue_rows(args, ws, gw, NGW, tid & 63); }
    enum { PH_CONV = 0, PH_GU = 1, PH_DOWN = 2, PH_QKV = 3, PH_ATTN = 4, PH_OUT = 5, PH_IN = 6, PH_PRE = 7, PH_SEQ = 8, PH_GATE = 9 };
#pragma unroll 1
    for (int layer = 0; layer < DEPTH; ++layer) {
        const int j = layer >> 1; const bool sb = (layer & 1) == 0; const int np = sb ? 8 : 10;
#pragma unroll 1
        for (int p = 0; p < np; ++p) {
            const int ab = p >= np - 2;
            const int kind = p == 0 ? PH_CONV : (p == 1 || p == np - 2) ? PH_GU : (p == 2 || p == np - 1) ? PH_DOWN : sb ? p : (p == 7 ? PH_OUT : p + 3);
            const bool fin = (layer == DEPTH - 1 && p == np - 1);
            switch (kind) {
            case PH_CONV: if (layer == 0) { const int tid = FRESH_TID(); conv_phase(args, ws, 0, 5, lds, gw, NGW, wave, tid & 63, blockIdx.x * NTHR + tid, GT); } break;
            case PH_GU: case PH_QKV: case PH_IN: {
                const int ek = kind == PH_GU ? 0 : kind == PH_QKV ? 1 : 2;
                const bf16* Wp = (const bf16*)(ws + (ek == 0 ? (ab ? WS_WGUB : WS_WGUA) : WS_WMIX)); const int NN = ek == 0 ? 2 * FF : ek == 1 ? 3 * D : GLA_INP;
                for (int rep = 0; rep < REP_GU; ++rep) {
                    pg8::EpiAny E{ek, pg8::EpiGU{ACT, SS}, pg8::EpiQKV{(bf16*)(ws + WS_Q), (size_t)(WS_K - WS_Q) / 2, SS, KIN(7) + j * 64, KIN(8) + j * 64, SB_VT_PITCH}, pg8::EpiGLAIn{(bf16*)(ws + WS_GP), (float*)(ws + WS_GGL), SS}};
                    run_gemm(lds, HB, Wp, NN, D, E, G); }
                {
                    const int idle0 = ek == 0 ? 150 : ek == 1 ? 12 : 77;
                    if ((int)blockIdx.x >= idle0) { const int tid = FRESH_TID(); const int b0 = (int)blockIdx.x - idle0, nb = G - idle0;
                        int p0 = -1, l0 = 0, p1 = -1, l1 = 0;
                        if (ek == 0 && !ab && layer == 0) { p0 = 3; l0 = 0; }
                        if (ek == 0 && ab && layer + 1 < DEPTH) { p0 = 3; l0 = layer + 1; }
                        if (ek == 1) { p0 = 1; l0 = layer; }
                        if (ek != 0 && layer + 1 < DEPTH) { p1 = 2; l1 = layer + 1; }
#pragma unroll 1
                        for (int q = 0; q < 2; ++q) { const int pp = q ? p1 : p0, ll = q ? l1 : l0; if (pp >= 0) conv_phase(args, ws, ll, pp, lds, b0 * NWAVES + wave, nb * NWAVES, wave, tid & 63, b0 * NTHR + tid, nb * NTHR); }
                    } }
                } break;
            case PH_DOWN: case PH_OUT: {
                const bool dn = kind == PH_DOWN;
                const bf16* Ap = dn ? ACT : (const bf16*)(ws + (sb ? WS_O : WS_GGA)); const bf16* Wp = (const bf16*)(ws + (dn ? (ab ? WS_WDB : WS_WDA) : WS_WO));
                const int KK = dn ? FF : D, ns = dn ? 11 : 4, gi = dn ? layer * 3 + 2 * ab : layer * 3 + 1; const float wr_ = dn ? 0.5f : 1.0f;
                pg8::EpiRes E{H, HB, SS, KOUT, wr_, (float*)(ws + WS_SLAB), (unsigned*)(ws + WS_CTL) + CW_CNT + 4 * gi, lds + 131072 + 1024, fin ? 1 : 0, ns}; run_gemm_split(lds, Ap, Wp, KK, ns, E, G); } break;
            case PH_ATTN: for (int rep = 0; rep < REP_SB; ++rep) { const int tid = FRESH_TID(); SB_ATTN_FN((const bf16*)(ws + WS_Q), (const bf16*)(ws + WS_K), (const bf16*)(ws + WS_V), (bf16*)(ws + WS_O), gw, NGW, tid & 63); } break;
            case PH_PRE: { const int tid = FRESH_TID(); gla_pre_phase((const bf16*)(ws + WS_GP), (const float*)(ws + WS_GGL), KIN(11) + (size_t)j * 16 * 512, KIN(12) + j * 512, (bf16*)(ws + WS_GQD), (bf16*)(ws + WS_GKST), (bf16*)(ws + WS_GATT), (bf16*)(ws + WS_GVT), (float*)(ws + WS_GDEC), lds, tid, wave, tid & 63, G); } break;
            case PH_SEQ: { const int tid = FRESH_TID(); gla_seq_phase((const bf16*)(ws + WS_GQD), (const bf16*)(ws + WS_GKST), (const bf16*)(ws + WS_GATT), (const bf16*)(ws + WS_GVT), (const float*)(ws + WS_GDEC), (float*)(ws + WS_GOG), lds, tid, wave, tid & 63, G); }
                if (wave >= 3) { const int tid = FRESH_TID(); conv_phase(args, ws, layer, 1, lds, blockIdx.x * 5 + (wave - 3), G * 5, wave, tid & 63, 0, 1); } break;
            default: for (int rep = 0; rep < REP_GATE; ++rep) { const int tid = FRESH_TID(); gla_gate_phase((const float*)(ws + WS_GOG), (const bf16*)(ws + WS_GP), KIN(13) + j * 1024, (bf16*)(ws + WS_GGA), gw, NGW, tid & 63); } break;
            }
            if (fin) break;
            if (kind == PH_CONV && layer > 0) continue;
            if (layer == 0 && p == 0) { grid.sync(); bar = xcd_barrier_post((unsigned*)(KWS + WS_CTL) + CW_BAR, MISC + 8); } else GRID_BAR();
        }
    }
}
#undef ws
#undef H
#undef HB
#undef SS
#undef ACT

extern "C" void kernel_launch(void* const* d_in, const int* in_sizes, int n_in, void* d_out, int out_size, void* d_ws, size_t ws_size, hipStream_t stream) {
    static int grid = 0;
    if (grid == 0) {
        if (n_in != 18 || ws_size < WS_END) { fprintf(stderr, "kernel_launch: expected 18 inputs and >= %zu bytes of workspace (got %d, %zu)\n", (size_t)WS_END, n_in, ws_size); grid = -1; return; }
        int dev = 0, cus = 0, per_cu = 0;
        hipGetDevice(&dev); hipDeviceGetAttribute(&cus, hipDeviceAttributeMultiprocessorCount, dev);
        if (hipFuncSetAttribute((const void*)fwd_megakernel, hipFuncAttributeMaxDynamicSharedMemorySize, LDS_BYTES) != hipSuccess) { fprintf(stderr, "kernel_launch: hipFuncSetAttribute failed\n"); grid = -1; return; }
        if (hipOccupancyMaxActiveBlocksPerMultiprocessor(&per_cu, (const void*)fwd_megakernel, NTHR, LDS_BYTES) != hipSuccess || per_cu < 1) { fprintf(stderr, "kernel_launch: occupancy query failed (%d)\n", per_cu); per_cu = 1; }
        (void)hipGetLastError();
        if (cus != 256) { fprintf(stderr, "kernel_launch: built for a 256-CU device (got %d)\n", cus); grid = -1; return; }
        grid = cus * 1;
    }
    if (grid < 0) return;
    Args a{};
    for (int i = 0; i < 18; ++i) a.in[i] = (const float*)d_in[i];
    a.out = (float*)d_out; a.ws = (unsigned char*)d_ws;
    void* kargs[] = {&a};
    hipError_t e = hipLaunchCooperativeKernel((const void*)fwd_megakernel, dim3(grid), dim3(NTHR), kargs, LDS_BYTES, stream);
    if (e != hipSuccess) fprintf(stderr, "kernel_launch: cooperative launch failed: %s (grid %d)\n", hipGetErrorString(e), grid);
}
```

```cpp
#include <hip/hip_runtime.h>
#include <hip/hip_cooperative_groups.h>
#include <cstdio>
#include <cstdint>

namespace pg8 {
#define PG8_LAS __attribute__((address_space(3)))
typedef unsigned short bf16_t;
typedef short bf16x8 __attribute__((ext_vector_type(8)));
typedef float f32x4 __attribute__((ext_vector_type(4)));
typedef unsigned u32x4 __attribute__((ext_vector_type(4)));
constexpr int BM = 256, BK = 64, HALF = 128, HTB = HALF * BK * 2  , STAGE_BYTES = 8 * HTB, NXCD = 8, WGM = 4;

__host__ __device__ __forceinline__ int lds_byte(int r, int c) { const int st = (r >> 4) * 2 + (c >> 5), rr = r & 15, cc = c & 31, ob = rr * 64 + cc * 2; return st * 1024 + (ob ^ (((ob >> 9) & 1) << 5)); }
__host__ __device__ __forceinline__ void stage_rc(int b, int& R, int& C) { const int st = b / 1024, sb = b % 1024, swz = sb ^ (((sb >> 9) & 1) << 5); R = (st >> 1) * 16 + swz / 64; C = (st & 1) * 32 + (swz % 64) / 2; }
__host__ __device__ __forceinline__ int perm32(int rho) { const int n = rho >> 4, i = rho & 15; return 8 * (i >> 2) + 4 * n + (i & 3); }

struct Unit { int pm, pn, kt0, nt; };
struct Gemm { const bf16_t* A; const bf16_t* Bt; int M, N, K; };

struct StaticOrder {
    int nM, nN, nwg, G, c, ntf;
    __host__ __device__ void init(int M, int N, int G_, int c_, int ntf_) { nM = M / BM; nN = N / BM; nwg = nM * nN; G = G_; c = c_; ntf = ntf_; }
    __host__ __device__ bool next(int i, Unit& u) const {
        const long L = (long)i * G + c; if (L >= nwg) return false;
        int wgid = (int)L; { const int q = nwg / NXCD, r = nwg % NXCD, xcd = wgid % NXCD, off = wgid / NXCD; wgid = (xcd < r ? xcd * (q + 1) : r * (q + 1) + (xcd - r) * q) + off; }
        const int nig = WGM * nN, gid = wgid / nig, fm = gid * WGM, gsz = (nM - fm) < WGM ? (nM - fm) : WGM;
        u.pm = fm + ((wgid % nig) % gsz); u.pn = (wgid % nig) / gsz; u.kt0 = 0; u.nt = ntf; return true;
    }
    __device__ __forceinline__ void a_ready(const Unit&) const {}
    __device__ __forceinline__ void done(const Unit&) const {}
};

__device__ __forceinline__ unsigned cvt_pk_bf16(float lo, float hi) { unsigned r; asm volatile("v_cvt_pk_bf16_f32 %0, %1, %2" : "=v"(r) : "v"(lo), "v"(hi)); return r; }
typedef float f32x2 __attribute__((ext_vector_type(2)));

struct SplitTailOrder {
    StaticOrder S0; int nsplit, c;
    __host__ __device__ void init(int G_, int c_, int ntf_, int nsplit_) { S0.init(64 * BM, 1024, G_, c_, ntf_); nsplit = nsplit_; c = c_; }
    __host__ __device__ bool next(int i, Unit& u) const {
        if (i == 0) return S0.next(0, u);
        if (i == 1 && c < 4 * nsplit) { u.pm = 64; u.pn = c & 3; u.nt = S0.ntf / nsplit; u.kt0 = (c >> 2) * u.nt; return true; }
        return false;
    }
    __device__ __forceinline__ void a_ready(const Unit&) const {}
    __device__ __forceinline__ void done(const Unit&) const {}
};
constexpr float RMS_EPS = 1e-6f;
constexpr int M_REAL = 16512, SEQ_L = 2064;
__device__ __forceinline__ float row_rs(const float* SS, int row, int fq) {
    const f32x4 a = *(const f32x4*)(SS + (size_t)row * 16 + 4 * fq);
    float s = (a[0] + a[1]) + (a[2] + a[3]);
    s += __shfl_xor(s, 16); s += __shfl_xor(s, 32);
    return __builtin_amdgcn_rsqf(s * (1.0f / 1024.0f) + RMS_EPS);
}
__device__ __forceinline__ void row_rs8(const float* SS, int row0, int fq, float (&rs)[2][4]) {
    f32x4 a[2][4];
#pragma unroll
    for (int ai = 0; ai < 2; ++ai)
#pragma unroll
        for (int m = 0; m < 4; ++m) a[ai][m] = *(const f32x4*)(SS + (size_t)(row0 + ai * HALF + m * 16) * 16 + 4 * fq);
#pragma unroll
    for (int ai = 0; ai < 2; ++ai)
#pragma unroll
        for (int m = 0; m < 4; ++m) { float s = (a[ai][m][0] + a[ai][m][1]) + (a[ai][m][2] + a[ai][m][3]); s += __shfl_xor(s, 16); s += __shfl_xor(s, 32); rs[ai][m] = __builtin_amdgcn_rsqf(s * (1.0f / 1024.0f) + RMS_EPS); }
}
__device__ __forceinline__ float silu_f(float g) { return g * __builtin_amdgcn_rcpf(1.0f + __expf(-g)); }

struct EpiGU {
    static constexpr bool PERM = true, AFTER_DRAIN = false;
    bf16_t* ACT; const float* SS;
    __device__ __forceinline__ void operator()(const f32x4 (&acc)[2][2][4][2], const Unit& u, int wr, int wc, int fr, int fq) const {
        const int row0 = u.pm * BM + wr * 64 + fr, col0 = u.pn * 128 + wc * 32 + 8 * fq;
        float rs8[2][4]; row_rs8(SS, row0, fq, rs8);
#pragma unroll
        for (int ai = 0; ai < 2; ++ai)
#pragma unroll
            for (int m = 0; m < 4; ++m) {
                const int row = row0 + ai * HALF + m * 16; const float rs = rs8[ai][m];
                float o[8];
#pragma unroll
                for (int n = 0; n < 2; ++n)
#pragma unroll
                    for (int j = 0; j < 4; ++j) { const float g = acc[ai][0][m][n][j] * rs, uu = acc[ai][1][m][n][j] * rs; o[4 * n + j] = silu_f(g) * uu; }
                u32x4 w; w.x = cvt_pk_bf16(o[0], o[1]); w.y = cvt_pk_bf16(o[2], o[3]); w.z = cvt_pk_bf16(o[4], o[5]); w.w = cvt_pk_bf16(o[6], o[7]);
                *(u32x4*)(ACT + (size_t)row * 2816 + col0) = w;
                asm volatile("" ::: "memory");
            }
    }
};

struct EpiRes {
    static constexpr bool PERM = true, AFTER_DRAIN = false;
    float* H; bf16_t* HB; float* SS; float* OUT; float wres; float* SLAB; unsigned* CNT; __attribute__((address_space(3))) unsigned char* lds_misc; int FINAL; int nsplit;
    __device__ __forceinline__ void operator()(const f32x4 (&acc)[2][2][4][2], const Unit& u, int wr, int wc, int fr, int fq) const {
        const int row0 = u.pm * BM + wr * 64 + fr, col0 = u.pn * BM + wc * 32 + 8 * fq;
        if (SLAB && u.pm == 64) {
            float* sp = SLAB + ((size_t)(u.kt0 / u.nt) * 256 + wr * 64 + fr) * 1024 + col0;
#pragma unroll
            for (int ai = 0; ai < 2; ++ai)
#pragma unroll
                for (int m = 0; m < 4; ++m)
#pragma unroll
                    for (int bj = 0; bj < 2; ++bj) { float* p = sp + (size_t)(ai * HALF + m * 16) * 1024 + bj * HALF; *(f32x4*)p = acc[ai][bj][m][0]; *(f32x4*)(p + 4) = acc[ai][bj][m][1]; }
            volatile __attribute__((address_space(3))) unsigned* lflag = (volatile __attribute__((address_space(3))) unsigned*)(lds_misc);
            asm volatile("s_waitcnt vmcnt(0)" ::: "memory"); __syncthreads();
            if (wr == 0 && wc == 0 && fr == 0 && fq == 0) { __builtin_amdgcn_fence(__ATOMIC_RELEASE, "agent"); asm volatile("s_waitcnt vmcnt(0)" ::: "memory");
                lflag[0] = __hip_atomic_fetch_add(CNT + u.pn, 1u, __ATOMIC_RELAXED, __HIP_MEMORY_SCOPE_AGENT); }
            __syncthreads();
            const bool last = (lflag[0] == (unsigned)(nsplit - 1));
            if (last) {
                __builtin_amdgcn_fence(__ATOMIC_ACQUIRE, "agent"); asm volatile("s_waitcnt vmcnt(0)" ::: "memory");
                const int lane = fq * 16 + fr, wv = wr * 4 + wc;
                constexpr int RB = 4;
                for (int r0 = wv * 16; r0 < wv * 16 + 16; r0 += RB) {
                    f32x4 a[RB]; unsigned long long hw[RB];
#pragma unroll
                    for (int q = 0; q < RB; ++q) {
                        f32x4 sl[11];
#pragma unroll
                        for (int s = 0; s < 11; ++s) sl[s] = s < nsplit ? *((const f32x4*)(SLAB + ((size_t)s * 256 + r0 + q) * 1024 + u.pn * BM) + lane) : (f32x4){0.f, 0.f, 0.f, 0.f};
                        hw[q] = *(const unsigned long long*)(HB + (size_t)(64 * 256 + r0 + q) * 1024 + u.pn * BM + 4 * lane);
                        a[q] = sl[0];
#pragma unroll
                        for (int s = 1; s < 11; ++s) a[q] += sl[s];
                    }
#pragma unroll
                    for (int q = 0; q < RB; ++q) {
                        const int row = 64 * 256 + r0 + q;
                        bf16_t* hbp = HB + (size_t)row * 1024 + u.pn * BM + 4 * lane;
                        const unsigned lo = (unsigned)hw[q], hi2 = (unsigned)(hw[q] >> 32);
                        const f32x4 v = (f32x4){__builtin_bit_cast(float, lo << 16), __builtin_bit_cast(float, lo & 0xffff0000u), __builtin_bit_cast(float, hi2 << 16), __builtin_bit_cast(float, hi2 & 0xffff0000u)} + a[q] * wres;
                        if (FINAL) { const int bb = row / SEQ_L, tt = row - bb * SEQ_L; if (tt >= 16) *((f32x4*)(OUT + ((size_t)bb * 2048 + (tt - 16)) * 1024 + u.pn * BM) + lane) = v; }
                        else { const unsigned w0 = cvt_pk_bf16(v[0], v[1]), w1 = cvt_pk_bf16(v[2], v[3]); *(unsigned long long*)hbp = (unsigned long long)w0 | ((unsigned long long)w1 << 32);
                            const float r0f = __builtin_bit_cast(float, w0 << 16), r1 = __builtin_bit_cast(float, w0 & 0xffff0000u), r2 = __builtin_bit_cast(float, w1 << 16), r3 = __builtin_bit_cast(float, w1 & 0xffff0000u);
                            float ss = (r0f * r0f + r1 * r1) + (r2 * r2 + r3 * r3);
#pragma unroll
                            for (int o = 1; o < 64; o <<= 1) ss += __shfl_xor(ss, o);
                            if (lane < 4) SS[(size_t)row * 16 + u.pn * 4 + lane] = lane == 0 ? ss : 0.f; }
                    }
                }
            }
            return;
        }
#pragma unroll
        for (int ai = 0; ai < 2; ++ai) {
            u32x4 hpre[4][2];
#pragma unroll
            for (int m = 0; m < 4; ++m)
#pragma unroll
                for (int bj = 0; bj < 2; ++bj) hpre[m][bj] = *(const u32x4*)(HB + (size_t)(row0 + ai * HALF + m * 16) * 1024 + col0 + bj * HALF);
#pragma unroll
            for (int m = 0; m < 4; ++m) {
                const int row = row0 + ai * HALF + m * 16; float ss = 0.f;
                bf16_t* hbp = HB + (size_t)row * 1024 + col0;
                const int bb = row / SEQ_L, tt = row - bb * SEQ_L;
#pragma unroll
                for (int bj = 0; bj < 2; ++bj) {
                    const u32x4 hw = hpre[m][bj];
                    const f32x4 h0 = (f32x4){__builtin_bit_cast(float, hw.x << 16), __builtin_bit_cast(float, hw.x & 0xffff0000u), __builtin_bit_cast(float, hw.y << 16), __builtin_bit_cast(float, hw.y & 0xffff0000u)};
                    const f32x4 h1 = (f32x4){__builtin_bit_cast(float, hw.z << 16), __builtin_bit_cast(float, hw.z & 0xffff0000u), __builtin_bit_cast(float, hw.w << 16), __builtin_bit_cast(float, hw.w & 0xffff0000u)};
                    const f32x4 v0 = h0 + acc[ai][bj][m][0] * wres, v1 = h1 + acc[ai][bj][m][1] * wres;
                    if (FINAL) {
                        if (row < M_REAL && tt >= 16) { float* op = OUT + ((size_t)bb * 2048 + (tt - 16)) * 1024 + col0 + bj * HALF; *(f32x4*)op = v0; *(f32x4*)(op + 4) = v1; }
                    } else {
                        u32x4 w; w.x = cvt_pk_bf16(v0[0], v0[1]); w.y = cvt_pk_bf16(v0[2], v0[3]); w.z = cvt_pk_bf16(v1[0], v1[1]); w.w = cvt_pk_bf16(v1[2], v1[3]);
                        *(u32x4*)(hbp + bj * HALF) = w;
                        const float r0 = __builtin_bit_cast(float, w.x << 16), r1 = __builtin_bit_cast(float, w.x & 0xffff0000u), r2 = __builtin_bit_cast(float, w.y << 16), r3 = __builtin_bit_cast(float, w.y & 0xffff0000u);
                        const float r4 = __builtin_bit_cast(float, w.z << 16), r5 = __builtin_bit_cast(float, w.z & 0xffff0000u), r6 = __builtin_bit_cast(float, w.w << 16), r7 = __builtin_bit_cast(float, w.w & 0xffff0000u);
                        ss += (r0 * r0 + r1 * r1) + (r2 * r2 + r3 * r3) + (r4 * r4 + r5 * r5) + (r6 * r6 + r7 * r7);
                    }
                }
                if (!FINAL) { ss += __shfl_xor(ss, 16); ss += __shfl_xor(ss, 32); if (fq == 0) SS[(size_t)row * 16 + u.pn * 4 + wc] = ss; }
            }
            asm volatile("" ::: "memory");
        }
    }
};

struct EpiQKV {
    static constexpr bool PERM = true, AFTER_DRAIN = false;
    bf16_t* QKV; size_t sec_stride; const float* SS; const float* gq; const float* gk; int VT_LP;
    __device__ __forceinline__ void operator()(const f32x4 (&acc)[2][2][4][2], const Unit& u, int wr, int wc, int fr, int fq) const {
        const int row0 = u.pm * BM + wr * 64 + fr; const int sec = u.pn >> 2, pt = u.pn & 3;
        const float* gn = sec == 0 ? gq : gk; bf16_t* dst = QKV + (size_t)sec * sec_stride;
        f32x4 gv[2][2];
#pragma unroll
        for (int bj = 0; bj < 2; ++bj)
#pragma unroll
            for (int n = 0; n < 2; ++n) gv[bj][n] = *(const f32x4*)(gn + 32 * bj + 8 * fq + 4 * n);
        float rs8[2][4]; row_rs8(SS, row0, fq, rs8);
#pragma unroll
        for (int ai = 0; ai < 2; ++ai)
#pragma unroll
            for (int m = 0; m < 4; ++m) {
                const int row = row0 + ai * HALF + m * 16; const float rs = rs8[ai][m];
                const int bb = row / SEQ_L, tt = row - bb * SEQ_L;
                f32x4 x[2][2];
#pragma unroll
                for (int bj = 0; bj < 2; ++bj)
#pragma unroll
                    for (int n = 0; n < 2; ++n) x[bj][n] = acc[ai][bj][m][n] * rs;
                if (sec < 2) {
                    float ss = 0.f;
#pragma unroll
                    for (int bj = 0; bj < 2; ++bj)
#pragma unroll
                        for (int n = 0; n < 2; ++n) ss += (x[bj][n][0] * x[bj][n][0] + x[bj][n][1] * x[bj][n][1]) + (x[bj][n][2] * x[bj][n][2] + x[bj][n][3] * x[bj][n][3]);
                    ss += __shfl_xor(ss, 16); ss += __shfl_xor(ss, 32);
                    const float r = __builtin_amdgcn_rsqf(ss * (1.0f / 64.0f) + RMS_EPS);
#pragma unroll
                    for (int bj = 0; bj < 2; ++bj)
#pragma unroll
                        for (int n = 0; n < 2; ++n) x[bj][n] = x[bj][n] * r * gv[bj][n];
                }
                if (row < M_REAL && sec == 2 && VT_LP) {
                    const int kt = tt >> 5, s = (tt >> 4) & 1, k16 = tt & 15, hl = (k16 >> 2) & 1, jj = (k16 & 3) + 4 * (k16 >> 3);
#pragma unroll
                    for (int bj = 0; bj < 2; ++bj) {
                        const int c = 256 * pt + 128 * bj + 32 * wc + 8 * fq, head = c >> 6, dim = c & 63;
                        bf16_t* vp = dst + (((size_t)(bb * 16 + head) * 65 + kt) * 2 + (dim >> 5)) * 1024 + ((dim & 31) + 32 * hl) * 16 + 8 * s + jj;
#pragma unroll
                        for (int n = 0; n < 2; ++n)
#pragma unroll
                            for (int i = 0; i < 4; ++i) vp[(4 * n + i) * 16] = (bf16_t)(cvt_pk_bf16(x[bj][n][i], x[bj][n][i]) & 0xffffu);
                    }
                } else if (row < M_REAL) {
#pragma unroll
                    for (int bj = 0; bj < 2; ++bj) {
                        int head, dim;
                        if (sec < 2) { head = 4 * pt + wc; dim = 32 * bj + 8 * fq; }
                        else { const int c = 256 * pt + 128 * bj + 32 * wc + 8 * fq; head = c >> 6; dim = c & 63; }
                        u32x4 w; w.x = cvt_pk_bf16(x[bj][0][0], x[bj][0][1]); w.y = cvt_pk_bf16(x[bj][0][2], x[bj][0][3]); w.z = cvt_pk_bf16(x[bj][1][0], x[bj][1][1]); w.w = cvt_pk_bf16(x[bj][1][2], x[bj][1][3]);
                        *(u32x4*)(dst + ((size_t)(bb * 16 + head) * SEQ_L + tt) * 64 + dim) = w;
                    }
                }
                asm volatile("" ::: "memory");
            }
    }
};

struct EpiGLAIn {
    static constexpr bool PERM = true, AFTER_DRAIN = false;
    bf16_t* P; float* GL; const float* SS;
    __device__ __forceinline__ void operator()(const f32x4 (&acc)[2][2][4][2], const Unit& u, int wr, int wc, int fr, int fq) const {
        const int row0 = u.pm * BM + wr * 64 + fr, col0 = u.pn * BM + wc * 32 + 8 * fq;
        float rs8[2][4]; row_rs8(SS, row0, fq, rs8);
#pragma unroll
        for (int ai = 0; ai < 2; ++ai)
#pragma unroll
            for (int m = 0; m < 4; ++m) {
                const int row = row0 + ai * HALF + m * 16; const float rs = rs8[ai][m];
                if (u.pn < 12) {
#pragma unroll
                    for (int bj = 0; bj < 2; ++bj) {
                        const f32x4 v0 = acc[ai][bj][m][0] * rs, v1 = acc[ai][bj][m][1] * rs;
                        u32x4 w; w.x = cvt_pk_bf16(v0[0], v0[1]); w.y = cvt_pk_bf16(v0[2], v0[3]); w.z = cvt_pk_bf16(v1[0], v1[1]); w.w = cvt_pk_bf16(v1[2], v1[3]);
                        *(u32x4*)(P + (size_t)row * 3072 + col0 + bj * HALF) = w;
                    }
                } else if (wc == 0 && fq < 2) {
                    const f32x4 v0 = acc[ai][0][m][0] * rs, v1 = acc[ai][0][m][1] * rs;
                    *(f32x4*)(GL + (size_t)row * 16 + 8 * fq) = v0; *(f32x4*)(GL + (size_t)row * 16 + 8 * fq + 4) = v1;
                }
                asm volatile("" ::: "memory");
            }
    }
};

struct EpiAny {
    static constexpr bool PERM = true, AFTER_DRAIN = false;
    int kind; EpiGU gu; EpiQKV qkv; EpiGLAIn gin;
    __device__ __forceinline__ void operator()(const f32x4 (&acc)[2][2][4][2], const Unit& u, int wr, int wc, int fr, int fq) const {
        if (kind == 0) gu(acc, u, wr, wc, fr, fq); else if (kind == 1) qkv(acc, u, wr, wc, fr, fq); else gin(acc, u, wr, wc, fr, fq);
    }
};
template <class Epi, class Sched, bool ALIGN_EPI = false, bool SP2 = false>
__device__ __forceinline__ void gemm_phase(PG8_LAS unsigned char* lds, const Gemm g, const Sched& S, const Epi& E) {
    int tid_ = threadIdx.x; asm volatile("" : "+v"(tid_)); const int tid = tid_, wid = __builtin_amdgcn_readfirstlane(tid >> 6), lane = tid & 63, wr = wid >> 2, wc = wid & 3, fr = lane & 15, fq = lane >> 4;
    const int K = g.K;
    unsigned voffA[2], voffB[2];
#pragma unroll
    for (int i = 0; i < 2; ++i) { int R, C; stage_rc(tid * 16 + i * 8192, R, C); const int Rb = Epi::PERM ? ((R & ~31) + perm32(R & 31)) : R;
        voffA[i] = (unsigned)(R * K + C) * 2u; voffB[i] = (unsigned)(Rb * K + C) * 2u; }
    const size_t kstep = (size_t)(BK * 2);
    const size_t hstep = (size_t)HALF * K * 2;
    const size_t tstep = 2 * hstep;
    const unsigned ldsw = (unsigned)wid * 1024u;
    const int aoff = lds_byte(wr * 64 + fr, fq * 8), boff = lds_byte(wc * 32 + fr, fq * 8);
#define PG8_SA(b, h) (((b) * 2 + (h)) * HTB)
#define PG8_SB(b, h) ((4 + (b) * 2 + (h)) * HTB)
#define PG8_STAGE(bufoff, gbase, voff) do { _Pragma("unroll") for (int _i = 0; _i < 2; ++_i) \
        __builtin_amdgcn_global_load_lds((const unsigned*)((const char*)(gbase) + (voff)[_i]), (PG8_LAS unsigned*)(lds + (bufoff) + ldsw + _i * 8192), 16, 0, 0); } while (0)
#define PG8_LDA(dst, b, h) do { _Pragma("unroll") for (int m = 0; m < 4; ++m) _Pragma("unroll") for (int k = 0; k < 2; ++k) dst[m][k] = *(const PG8_LAS bf16x8*)(lds + PG8_SA(b, h) + aoff + m * 2048 + k * 1024); } while (0)
#define PG8_LDB(dst, b, h) do { _Pragma("unroll") for (int n = 0; n < 2; ++n) _Pragma("unroll") for (int k = 0; k < 2; ++k) dst[n][k] = *(const PG8_LAS bf16x8*)(lds + PG8_SB(b, h) + boff + n * 2048 + k * 1024); } while (0)
#define PG8_MMA(ai, bj, At, Bt) do { __builtin_amdgcn_s_setprio(1); _Pragma("unroll") for (int m = 0; m < 4; ++m) _Pragma("unroll") for (int n = 0; n < 2; ++n) _Pragma("unroll") for (int k = 0; k < 2; ++k) \
        acc[ai][bj][m][n] = __builtin_amdgcn_mfma_f32_16x16x32_bf16(Bt[n][k], At[m][k], acc[ai][bj][m][n], 0, 0, 0); __builtin_amdgcn_s_setprio(0); } while (0)
#define PG8_WAIT_V(n) asm volatile("s_waitcnt vmcnt(" #n ")" ::: "memory")
#define PG8_WAIT_L(n) asm volatile("s_waitcnt lgkmcnt(" #n ")" ::: "memory")
#define PG8_BAR __builtin_amdgcn_s_barrier()
#define PG8_SCHED __builtin_amdgcn_sched_barrier(0)
    Unit cur, nxt; int ui = 0;
    if (!S.next(0, cur)) return;
    f32x4 acc[2][2][4][2];
#pragma unroll
    for (int a = 0; a < 2; ++a)
#pragma unroll
        for (int b = 0; b < 2; ++b)
#pragma unroll
            for (int m = 0; m < 4; ++m)
#pragma unroll
                for (int n = 0; n < 2; ++n) acc[a][b][m][n] = (f32x4){0.f, 0.f, 0.f, 0.f};
    bf16x8 At[4][2], B0[2][2], B1[2][2];
    const char* cA = (const char*)g.A + (size_t)cur.pm * tstep + (size_t)cur.kt0 * kstep; const char* cB = (const char*)g.Bt + (size_t)cur.pn * tstep + (size_t)cur.kt0 * kstep;
    S.a_ready(cur);
    if constexpr (SP2) {
        PG8_STAGE(PG8_SB(0, 0), cB, voffB); PG8_STAGE(PG8_SB(0, 1), cB + hstep, voffB); PG8_STAGE(PG8_SA(0, 0), cA, voffA); PG8_STAGE(PG8_SA(0, 1), cA + hstep, voffA);
        if (wr == 1) PG8_BAR;
        PG8_WAIT_V(2); PG8_BAR;
        PG8_STAGE(PG8_SB(1, 0), cB + kstep, voffB); PG8_STAGE(PG8_SA(1, 0), cA + kstep, voffA); PG8_STAGE(PG8_SB(1, 1), cB + hstep + kstep, voffB);
        PG8_WAIT_V(6); PG8_BAR;
    } else {
        PG8_STAGE(PG8_SB(0, 0), cB, voffB); PG8_STAGE(PG8_SA(0, 0), cA, voffA); PG8_STAGE(PG8_SB(0, 1), cB + hstep, voffB); PG8_STAGE(PG8_SA(0, 1), cA + hstep, voffA);
        if (wr == 1) PG8_BAR;
        PG8_WAIT_V(4); PG8_BAR;
        PG8_STAGE(PG8_SB(1, 0), cB + kstep, voffB); PG8_STAGE(PG8_SA(1, 0), cA + kstep, voffA); PG8_STAGE(PG8_SB(1, 1), cB + hstep + kstep, voffB);
        PG8_WAIT_V(6); PG8_BAR;
    }
    for (;;) {
        const bool has_next = S.next(ui + 1, nxt);
        const char* nA = has_next ? (const char*)g.A + (size_t)nxt.pm * tstep + (size_t)nxt.kt0 * kstep : cA; const char* nB = has_next ? (const char*)g.Bt + (size_t)nxt.pn * tstep + (size_t)nxt.kt0 * kstep : cB;
        const int nt = cur.nt;
        for (int t = 0; t < nt; t += 2) {
            const bool last = (t == nt - 2);
            const char* a1 = cA + (size_t)(t + 1) * kstep;
            const char* a2 = last ? nA : cA + (size_t)(t + 2) * kstep; const char* b2 = last ? nB : cB + (size_t)(t + 2) * kstep;
            const char* a3 = a2 + kstep; const char* b3 = b2 + kstep;
            if (last && has_next) S.a_ready(nxt);
            if constexpr (SP2) {
            PG8_LDB(B0, 0, 0); PG8_LDB(B1, 0, 1); PG8_SCHED; PG8_LDA(At, 0, 0); PG8_STAGE(PG8_SA(1, 1), a1 + hstep, voffA);
            PG8_WAIT_V(8); PG8_WAIT_L(0); PG8_BAR; PG8_MMA(0, 0, At, B0); PG8_MMA(0, 1, At, B1); PG8_BAR; PG8_SCHED;
            PG8_LDA(At, 0, 1); PG8_STAGE(PG8_SB(0, 0), b2, voffB); PG8_STAGE(PG8_SB(0, 1), b2 + hstep, voffB); PG8_STAGE(PG8_SA(0, 0), a2, voffA);
            PG8_WAIT_V(8); PG8_WAIT_L(0); PG8_BAR; PG8_MMA(1, 0, At, B0); PG8_MMA(1, 1, At, B1); PG8_BAR; PG8_SCHED;
            PG8_LDB(B0, 1, 0); PG8_LDB(B1, 1, 1); PG8_SCHED; PG8_LDA(At, 1, 0); PG8_STAGE(PG8_SA(0, 1), a2 + hstep, voffA);
            PG8_WAIT_V(8); PG8_WAIT_L(0); PG8_BAR; PG8_MMA(0, 0, At, B0); PG8_MMA(0, 1, At, B1); PG8_BAR; PG8_SCHED;
            PG8_LDA(At, 1, 1); PG8_STAGE(PG8_SB(1, 0), b3, voffB); PG8_STAGE(PG8_SB(1, 1), b3 + hstep, voffB); PG8_STAGE(PG8_SA(1, 0), a3, voffA);
            PG8_WAIT_V(8); PG8_WAIT_L(0); PG8_BAR; PG8_MMA(1, 0, At, B0); PG8_MMA(1, 1, At, B1); PG8_BAR; PG8_SCHED;
            } else {
            PG8_LDB(B0, 0, 0); PG8_SCHED; PG8_LDA(At, 0, 0); PG8_STAGE(PG8_SA(1, 1), a1 + hstep, voffA);
            PG8_WAIT_L(8); PG8_BAR; PG8_WAIT_L(0); PG8_MMA(0, 0, At, B0); PG8_BAR; PG8_SCHED;
            PG8_LDB(B1, 0, 1); PG8_STAGE(PG8_SB(0, 0), b2, voffB);
            PG8_BAR; PG8_WAIT_L(0); PG8_MMA(0, 1, At, B1); PG8_BAR;
            PG8_LDA(At, 0, 1); PG8_STAGE(PG8_SA(0, 0), a2, voffA);
            PG8_BAR; PG8_WAIT_L(0); PG8_MMA(1, 0, At, B0); PG8_BAR; PG8_SCHED;
            PG8_STAGE(PG8_SB(0, 1), b2 + hstep, voffB);
            PG8_WAIT_V(6); PG8_BAR; PG8_MMA(1, 1, At, B1); PG8_BAR;
            PG8_LDB(B0, 1, 0); PG8_SCHED; PG8_LDA(At, 1, 0); PG8_STAGE(PG8_SA(0, 1), a2 + hstep, voffA);
            PG8_WAIT_L(8); PG8_BAR; PG8_WAIT_L(0); PG8_MMA(0, 0, At, B0); PG8_BAR; PG8_SCHED;
            PG8_LDB(B1, 1, 1); PG8_STAGE(PG8_SB(1, 0), b3, voffB);
            PG8_BAR; PG8_WAIT_L(0); PG8_MMA(0, 1, At, B1); PG8_BAR;
            PG8_LDA(At, 1, 1); PG8_STAGE(PG8_SA(1, 0), a3, voffA);
            PG8_BAR; PG8_WAIT_L(0); PG8_MMA(1, 0, At, B0); PG8_BAR; PG8_SCHED;
            PG8_STAGE(PG8_SB(1, 1), b3 + hstep, voffB);
            PG8_WAIT_V(6); PG8_BAR; PG8_MMA(1, 1, At, B1); PG8_BAR;
            }
        }
        if constexpr (ALIGN_EPI) { if (wr == 0) PG8_BAR; }
        if constexpr (!Epi::AFTER_DRAIN) { E(acc, cur, wr, wc, fr, fq); S.done(cur); }
        if (!has_next) break;
#pragma unroll
        for (int a = 0; a < 2; ++a)
#pragma unroll
            for (int b = 0; b < 2; ++b)
#pragma unroll
                for (int m = 0; m < 4; ++m)
#pragma unroll
                    for (int n = 0; n < 2; ++n) acc[a][b][m][n] = (f32x4){0.f, 0.f, 0.f, 0.f};
        cur = nxt; cA = nA; cB = nB; ++ui;
        if constexpr (ALIGN_EPI) { if (wr == 1) PG8_BAR; }
    }
    PG8_WAIT_V(0);
    if constexpr (!ALIGN_EPI) { if (wr == 0) PG8_BAR; }
    PG8_BAR;
    if constexpr (Epi::AFTER_DRAIN) { E.fused(acc, cur, wr, wc, fr, fq, lds, wid, lane); S.done(cur); }
#undef PG8_SA
#undef PG8_SB
#undef PG8_STAGE
#undef PG8_LDA
#undef PG8_LDB
#undef PG8_MMA
#undef PG8_WAIT_V
#undef PG8_WAIT_L
#undef PG8_BAR
#undef PG8_SCHED
}
}
namespace cg = cooperative_groups;
#define LAS __attribute__((address_space(3)))
typedef unsigned short bf16;
typedef unsigned v4u __attribute__((ext_vector_type(4)));
typedef unsigned v2u __attribute__((ext_vector_type(2)));
typedef float f32x4 __attribute__((ext_vector_type(4)));
constexpr int NWAVES = 8, NTHR = 512;
constexpr int NB = 8, SEQ = 2048, NMETA = 16, L = 2064, D = 1024, FF = 2816, DEPTH = 4;
constexpr int M = NB * L;
constexpr int MP = 16640;
constexpr int GLA_IN = 3088, GLA_INP = 3328;
constexpr size_t MiB = 1u << 20;
constexpr size_t WS_SS = 1 * MiB, WS_H = 3 * MiB, WS_HB = 68 * MiB;
constexpr size_t WS_WGUA = 101 * MiB, WS_WDA = 112 * MiB, WS_WGUB = 118 * MiB, WS_WDB = 129 * MiB, WS_WMIX = 135 * MiB, WS_WO = 142 * MiB;
constexpr size_t WS_ACT = 144 * MiB;
constexpr size_t WS_Q = 144 * MiB, WS_K = 177 * MiB, WS_V = 210 * MiB, WS_O = 243 * MiB;
constexpr size_t WS_GP = 144 * MiB, WS_GGL = 242 * MiB, WS_GA = 244 * MiB, WS_GOG = 277 * MiB, WS_GGA = 343 * MiB, WS_SLAB = 376 * MiB, WS_END = 388 * MiB;
static_assert(WS_V - WS_K == WS_K - WS_Q, "Q|K|V equally spaced");
constexpr int LDS_BYTES = 147456;

__device__ __forceinline__ unsigned f2bf(float f) { unsigned u = __builtin_bit_cast(unsigned, f); return (u + 0x7fffu + ((u >> 16) & 1u)) >> 16; }
typedef float f32x2_t __attribute__((ext_vector_type(2))); typedef __bf16 bf16x2_t __attribute__((ext_vector_type(2)));
__device__ __forceinline__ unsigned pk2(float lo, float hi) { const f32x2_t v = {lo, hi}; return __builtin_bit_cast(unsigned, __builtin_convertvector(v, bf16x2_t)); }
__device__ __forceinline__ float bflo(unsigned u) { return __builtin_bit_cast(float, u << 16); }
__device__ __forceinline__ float bfhi(unsigned u) { return __builtin_bit_cast(float, u & 0xffff0000u); }
__device__ __forceinline__ float wave_sum(float v) {
#pragma unroll
    for (int o = 1; o < 64; o <<= 1) v += __shfl_xor(v, o);
    return v;
}

constexpr size_t WS_CTL = 0, CTL_ZERO_BYTES = 65536; constexpr int CW_BAR = 4096, CW_CNT = 8192;
typedef __attribute__((address_space(1))) unsigned gu32;
#define XB_TMO      128
#define XB_XCNT(j)  (256  + 64 * (j))
#define XB_XSUB(j)  (1280 + 64 * (j))
#define XB_XGEN(j)  (2304 + 64 * (j))
#define XB_TOP      3328
#define XB_TOPGEN   3392
#define XCD_BAR_WORDS 3456
#define XB_SPIN_CAP (1u << 18)

__device__ __forceinline__ unsigned xb_ld(unsigned* p)              { return __hip_atomic_load(p, __ATOMIC_RELAXED, __HIP_MEMORY_SCOPE_AGENT); }
__device__ __forceinline__ unsigned xb_add(unsigned* p, unsigned v) { return __hip_atomic_fetch_add(p, v, __ATOMIC_RELAXED, __HIP_MEMORY_SCOPE_AGENT); }
__device__ __forceinline__ unsigned xb_xcc_id() { return (unsigned)__builtin_amdgcn_s_getreg((3 << 11) | 20) & 0xFu; }
#define XB_SPIN(cond, bar) do { unsigned _sp = 0; while (cond) { __builtin_amdgcn_s_sleep(1); \
    if ((++_sp & 255u) == 0u) { if (xb_ld(&(bar)[XB_TMO])) break; if (_sp > XB_SPIN_CAP) { atomicAdd(&(bar)[XB_TMO], 1u); break; } } } } while (0)

struct XcdBarrier {
    unsigned* bar; unsigned x;
    volatile LAS unsigned* st;
};

__device__ __forceinline__ XcdBarrier xcd_barrier_post(unsigned* bar, volatile LAS unsigned* st) {
    XcdBarrier b; b.bar = bar; b.x = xb_xcc_id(); b.st = st;
    if (threadIdx.x == 0) (void)xb_add(&bar[XB_XCNT(b.x)], 1u);
    return b;
}
__device__ __forceinline__ void xcd_barrier_complete(unsigned* bar, unsigned x, unsigned& nloc, unsigned& nx) {
    const unsigned G = gridDim.x * gridDim.y * gridDim.z;
    unsigned sum, cnt, mine, sp = 0u;
    for (;;) {
        sum = 0u; cnt = 0u; mine = 0u;
#pragma unroll
        for (unsigned j = 0; j < 16; ++j) { const unsigned c = xb_ld(&bar[XB_XCNT(j)]); sum += c; cnt += (c > 0u) ? 1u : 0u; mine = (j == x) ? c : mine; }
        if (sum == G) break;
        __builtin_amdgcn_s_sleep(1);
        if ((++sp & 255u) == 0u) { if (xb_ld(&bar[XB_TMO])) break; if (sp > XB_SPIN_CAP) { atomicAdd(&bar[XB_TMO], 1u); break; } }
    }
    nloc = mine > 0u ? mine : 1u; nx = cnt > 0u ? cnt : 1u;
}

__device__ __forceinline__ void xcd_barrier(const XcdBarrier& b) {
    asm volatile("s_waitcnt vmcnt(0)" ::: "memory");
    __syncthreads();
    if (threadIdx.x == 0) {
        unsigned* bar = b.bar;
        __builtin_amdgcn_s_waitcnt(0);
        unsigned nloc = b.st[0], nx = b.st[1];
        if (nloc == 0u) { xcd_barrier_complete(bar, b.x, nloc, nx); b.st[0] = nloc; b.st[1] = nx; }
        const unsigned old = xb_add(&bar[XB_XSUB(b.x)], 1u);
        const unsigned gen = old / nloc;
        if (old + 1u == (gen + 1u) * nloc) {
            __builtin_amdgcn_fence(__ATOMIC_RELEASE, "agent");
            asm volatile("s_waitcnt vmcnt(0)" ::: "memory");
            const unsigned og = xb_add(&bar[XB_TOP], 1u);
            const unsigned tg = og / nx;
            if (og + 1u == (tg + 1u) * nx) xb_add(&bar[XB_TOPGEN], 1u);
            else XB_SPIN(xb_ld(&bar[XB_TOPGEN]) == tg, bar);
            __builtin_amdgcn_fence(__ATOMIC_ACQUIRE, "agent");
            xb_add(&bar[XB_XGEN(b.x)], 1u);
            asm volatile("s_waitcnt vmcnt(0)" ::: "memory");
        } else {
            XB_SPIN(xb_ld(&bar[XB_XGEN(b.x)]) == gen, bar);
            __builtin_amdgcn_fence(__ATOMIC_ACQUIRE, "agent");
            asm volatile("s_waitcnt vmcnt(0)" ::: "memory");
        }
    }
    __syncthreads();
}

struct Args { const float* in[18]; float* out; unsigned char* ws; };
typedef const __attribute__((address_space(4))) unsigned char* kptr_t;
__device__ __forceinline__ unsigned long long karg(int i) { kptr_t ka = (kptr_t)__builtin_amdgcn_kernarg_segment_ptr(); asm volatile("" : "+s"(ka)); return *(const __attribute__((address_space(4))) unsigned long long*)(ka + 8 * i); }
#define KIN(i) ((const float*)(const __attribute__((address_space(1))) float*)karg(i))
#define KOUT ((float*)(__attribute__((address_space(1))) float*)karg(18))
#define KWS ((unsigned char*)(__attribute__((address_space(1))) unsigned char*)karg(19))

struct ConvP { const float* src; const float* gain; bf16* dst; int ldw, K; };
__device__ __forceinline__ int gu_dest(int c) { return c < FF ? 256 * (c >> 7) + (c & 127) : 256 * ((c - FF) >> 7) + 128 + ((c - FF) & 127); }
__device__ __forceinline__ int qkv_dest(int c) {
    const int sec = c >> 10, cc = c & 1023; if (sec == 2) return c;
    const int head = cc >> 6, dd = cc & 63; return 1024 * sec + 256 * (head >> 2) + 128 * (dd >> 5) + 32 * (head & 3) + (dd & 31);
}
constexpr int CONV_I_GU = 16 * 176, CONV_I_D = 44 * 32, CONV_I_IN = 16 * 96, CONV_I_O = 16 * 32, CONV_NIT = 2 * (CONV_I_GU + CONV_I_D) + CONV_I_IN + CONV_I_O;
__device__ __forceinline__ ConvP conv_params(int it, int layer, unsigned char* ws) {
    const int j = layer >> 1; const bool sb = (layer & 1) == 0;
    const float* W; const float* gain = nullptr; bf16* WT; int ldw, K, kb, nb, dest0;
    int r = it;
    if (r < CONV_I_GU) { kb = r / 176; nb = r % 176; W = KIN(3) + (size_t)layer * D * 2 * FF; ldw = 2 * FF; K = D; WT = (bf16*)(ws + WS_WGUA); dest0 = gu_dest(32 * nb); gain = KIN(2) + layer * D; }
    else if ((r -= CONV_I_GU) < CONV_I_D) { kb = r / 32; nb = r % 32; W = KIN(4) + (size_t)layer * FF * D; ldw = D; K = FF; WT = (bf16*)(ws + WS_WDA); dest0 = 32 * nb; }
    else if ((r -= CONV_I_D) < CONV_I_GU) { kb = r / 176; nb = r % 176; W = KIN(16) + (size_t)layer * D * 2 * FF; ldw = 2 * FF; K = D; WT = (bf16*)(ws + WS_WGUB); dest0 = gu_dest(32 * nb); gain = KIN(15) + layer * D; }
    else if ((r -= CONV_I_GU) < CONV_I_D) { kb = r / 32; nb = r % 32; W = KIN(17) + (size_t)layer * FF * D; ldw = D; K = FF; WT = (bf16*)(ws + WS_WDB); dest0 = 32 * nb; }
    else if ((r -= CONV_I_D) < CONV_I_IN) { kb = r / 96; nb = r % 96; K = D; WT = (bf16*)(ws + WS_WMIX); gain = KIN(5) + layer * D;
        if (sb) { W = KIN(6) + (size_t)j * D * 3 * D; ldw = 3 * D; dest0 = qkv_dest(32 * nb); } else { W = KIN(10) + (size_t)j * D * GLA_IN; ldw = GLA_IN; dest0 = 32 * nb; } }
    else { r -= CONV_I_IN; kb = r / 32; nb = r % 32; W = (sb ? KIN(9) : KIN(14)) + (size_t)j * D * D; ldw = D; K = D; WT = (bf16*)(ws + WS_WO); dest0 = 32 * nb; }
    ConvP p; p.src = W + (size_t)(64 * kb) * ldw + 32 * nb; p.gain = gain ? gain + 64 * kb : nullptr; p.dst = WT + (size_t)dest0 * K + 64 * kb; p.ldw = ldw; p.K = K; return p;
}
__device__ __forceinline__ void conv_load(const ConvP& p, int lane, f32x4 (&v)[8], float (&g)[8]) {
    const int c4 = lane & 7, r8 = lane >> 3;
#pragma unroll
    for (int i = 0; i < 8; ++i) { v[i] = *(const f32x4*)(p.src + (size_t)(8 * i + r8) * p.ldw + 4 * c4); g[i] = p.gain ? p.gain[8 * i + r8] : 1.0f; }
}
__device__ __forceinline__ void conv_store(const ConvP& p, int lane, const f32x4 (&v)[8], const float (&g)[8], LAS float* scr) {
    const int c4 = lane & 7, r8 = lane >> 3;
#pragma unroll
    for (int i = 0; i < 8; ++i) { LAS float* s = scr + (8 * i + r8) * 33 + 4 * c4; s[0] = v[i][0] * g[i]; s[1] = v[i][1] * g[i]; s[2] = v[i][2] * g[i]; s[3] = v[i][3] * g[i]; }
    asm volatile("s_waitcnt lgkmcnt(0)" ::: "memory");
    const int c = lane & 7;
#pragma unroll
    for (int jj = 0; jj < 4; ++jj) { const int n = (lane >> 3) + 8 * jj; const LAS float* s = scr + (8 * c) * 33 + n;
        v4u o; o.x = pk2(s[0 * 33], s[1 * 33]); o.y = pk2(s[2 * 33], s[3 * 33]); o.z = pk2(s[4 * 33], s[5 * 33]); o.w = pk2(s[6 * 33], s[7 * 33]);
        *(v4u*)(p.dst + (size_t)n * p.K + 8 * c) = o; }
    asm volatile("s_waitcnt lgkmcnt(0)" ::: "memory");
}
__device__ __forceinline__ int conv_item_index(int ci, int part) {
    constexpr int AB = CONV_I_GU + CONV_I_D;
    return part == 0 ? (ci < AB ? ci : ci + AB) : part == 1 ? ci + AB : (part == 2 || part == 5) ? ci : ci + 2 * AB;
}
__device__ __forceinline__ void conv_phase(const Args& a, unsigned char* ws, int layer, int part, LAS unsigned char* lds, int gw, int NGW, int wave, int lane, int gtid, int GT) {
    LAS float* scr = (LAS float*)(lds + wave * 16384);
    const int j = layer >> 1; const bool sb = (layer & 1) == 0;
    constexpr int AB = CONV_I_GU + CONV_I_D;
    const int ncomp = part == 0 ? CONV_NIT - AB : part == 3 ? CONV_I_IN + CONV_I_O : AB;
    if (gw < ncomp) {
        ConvP cur = conv_params(conv_item_index(gw, part), layer, ws); f32x4 v[8]; float g[8];
        conv_load(cur, lane, v, g);
#pragma unroll 1
        for (int ci = gw; ci < ncomp; ci += NGW) {
            const bool has = ci + NGW < ncomp;
            ConvP nxt = conv_params(conv_item_index(has ? ci + NGW : ci, part), layer, ws); f32x4 vn[8]; float gn[8];
            conv_load(nxt, lane, vn, gn);
            conv_store(cur, lane, v, g, scr);
            cur = nxt;
#pragma unroll
            for (int i = 0; i < 8; ++i) { v[i] = vn[i]; g[i] = gn[i]; }
        }
    }
    if (!sb && (part == 0 || part == 3)) {
        const float* W = KIN(10) + (size_t)j * D * GLA_IN; const float* gain = KIN(5) + layer * D; bf16* WT = (bf16*)(ws + WS_WMIX) + (size_t)3072 * D;
        for (int idx = gtid; idx < 256 * D; idx += GT) { const int r = idx >> 10, k = idx & 1023; WT[idx] = (bf16)(r < 16 ? f2bf(W[(size_t)k * GLA_IN + 3072 + r] * gain[k]) : 0u); }
    }
}

__device__ __forceinline__ void prologue_rows(const Args& a, unsigned char* ws, int gw, int NGW, int lane) {
    float* H = (float*)(ws + WS_H); bf16* HB = (bf16*)(ws + WS_HB); float* SS = (float*)(ws + WS_SS);
    for (int m = gw; m < MP; m += NGW) {
        f32x4 v[4]; float s = 0.f;
        if (m < M) { const int b = m / L, t = m - b * L; const float* src = t < NMETA ? KIN(1) + (size_t)t * D : KIN(0) + ((size_t)b * SEQ + (t - NMETA)) * D;
#pragma unroll
            for (int j = 0; j < 4; ++j) { v[j] = *((const f32x4*)src + lane + 64 * j); s += (v[j][0] * v[j][0] + v[j][1] * v[j][1]) + (v[j][2] * v[j][2] + v[j][3] * v[j][3]); }
        } else {
#pragma unroll
            for (int j = 0; j < 4; ++j) v[j] = (f32x4){0.f, 0.f, 0.f, 0.f};
        }
        s = 0.f;
#pragma unroll
        for (int j = 0; j < 4; ++j) { v2u w; w.x = pk2(v[j][0], v[j][1]); w.y = pk2(v[j][2], v[j][3]); *((v2u*)(HB + (size_t)m * D) + lane + 64 * j) = w;
            const float r0 = bflo(w.x), r1 = bfhi(w.x), r2 = bflo(w.y), r3 = bfhi(w.y); s += (r0 * r0 + r1 * r1) + (r2 * r2 + r3 * r3); }
        s = wave_sum(s);
        if (lane < 16) SS[(size_t)m * 16 + lane] = lane == 0 ? s : 0.f;
    }
}

__device__ __forceinline__ void sb_attn_phase(const bf16* Q, const bf16* K, const bf16* V, bf16* O, int gw, int NGW, int lane) {
    constexpr int NQB = (L + 63) / 64;
    for (int wu = gw; wu < NB * 16 * NQB; wu += NGW) {
        const int bh = wu / NQB, qb = wu - bh * NQB; const int t = qb * 64 + lane; const bool valid = t < L;
        const size_t base = (size_t)bh * L * 64;
        float q[64], o[64];
        if (valid) {
            const v4u* qp = (const v4u*)(Q + base + (size_t)t * 64);
#pragma unroll
            for (int c = 0; c < 8; ++c) { const v4u r = qp[c];
                q[8 * c + 0] = bflo(r.x) * 0.125f; q[8 * c + 1] = bfhi(r.x) * 0.125f; q[8 * c + 2] = bflo(r.y) * 0.125f; q[8 * c + 3] = bfhi(r.y) * 0.125f;
                q[8 * c + 4] = bflo(r.z) * 0.125f; q[8 * c + 5] = bfhi(r.z) * 0.125f; q[8 * c + 6] = bflo(r.w) * 0.125f; q[8 * c + 7] = bfhi(r.w) * 0.125f; }
        } else {
#pragma unroll
            for (int c = 0; c < 64; ++c) q[c] = 0.f;
        }
#pragma unroll
        for (int c = 0; c < 64; ++c) o[c] = 0.f;
        float carry = 0.f;
        for (int i = 1; i < L; ++i) {
            const int s = t - i; const bool act = valid && s >= 0 && carry > -104.0f;
            if (__ballot(act) == 0ull) break;
            if (act) {
                const v4u* kp = (const v4u*)(K + base + (size_t)s * 64);
                float z0 = 0.f, z1 = 0.f;
#pragma unroll
                for (int c = 0; c < 8; ++c) { const v4u r = kp[c];
                    z0 += q[8 * c + 0] * bflo(r.x); z1 += q[8 * c + 1] * bfhi(r.x); z0 += q[8 * c + 2] * bflo(r.y); z1 += q[8 * c + 3] * bfhi(r.y);
                    z0 += q[8 * c + 4] * bflo(r.z); z1 += q[8 * c + 5] * bfhi(r.z); z0 += q[8 * c + 6] * bflo(r.w); z1 += q[8 * c + 7] * bfhi(r.w); }
                const float z = z0 + z1;
                const float sp = fmaxf(z, 0.f) + __logf(1.0f + __expf(-fabsf(z)));
                const float w = __expf(z - sp + carry);
                carry -= sp;
                const v4u* vp = (const v4u*)(V + base + (size_t)s * 64);
#pragma unroll
                for (int c = 0; c < 8; ++c) { const v4u r = vp[c];
                    o[8 * c + 0] += w * bflo(r.x); o[8 * c + 1] += w * bfhi(r.x); o[8 * c + 2] += w * bflo(r.y); o[8 * c + 3] += w * bfhi(r.y);
                    o[8 * c + 4] += w * bflo(r.z); o[8 * c + 5] += w * bfhi(r.z); o[8 * c + 6] += w * bflo(r.w); o[8 * c + 7] += w * bfhi(r.w); }
            }
        }
        if (valid) {
            const int b = bh >> 4, h = bh & 15;
            v4u* op = (v4u*)(O + ((size_t)b * L + t) * D + h * 64);
#pragma unroll
            for (int c = 0; c < 8; ++c) { v4u w; w.x = pk2(o[8 * c + 0], o[8 * c + 1]); w.y = pk2(o[8 * c + 2], o[8 * c + 3]); w.z = pk2(o[8 * c + 4], o[8 * c + 5]); w.w = pk2(o[8 * c + 6], o[8 * c + 7]); op[c] = w; }
        }
    }
}


typedef short bf16x8_t __attribute__((ext_vector_type(8)));
typedef float f32x16 __attribute__((ext_vector_type(16)));
constexpr int SB_LP = 2080;
__device__ __forceinline__ void sb_attn_mfma(const bf16* Q, const bf16* K, const bf16* VT, bf16* O, int gw, int NGW, int lane) {
    constexpr int NQB = (L + 31) / 32;
    const int ql = lane & 31, hi = lane >> 5;
    const int UPW = (128 * (NQB - 1) + NGW - 1) / NGW;
    for (int it = 0; it <= UPW; ++it) {
        int bh, qb;
        if (it < UPW) { const int w2 = gw * UPW + it; if (w2 >= 128 * (NQB - 1)) continue; bh = w2 / (NQB - 1); qb = w2 - bh * (NQB - 1) + 1; }
        else { if (gw >= 128) break; bh = gw; qb = 0; }
        const int tq = 32 * qb + ql; const bool valid = tq < L; const int tqc = valid ? tq : L - 1;
        const bf16* Qb = Q + (size_t)bh * L * 64; const bf16* Kb = K + (size_t)bh * L * 64; const bf16* Vb = VT + (size_t)bh * 65 * 2048;
        bf16x8_t qf[4];
#pragma unroll
        for (int t = 0; t < 4; ++t) qf[t] = *(const bf16x8_t*)(Qb + (size_t)tqc * 64 + 16 * t + 8 * hi);
        f32x16 o0, o1;
#pragma unroll
        for (int r = 0; r < 16; ++r) { o0[r] = 0.f; o1[r] = 0.f; }
        float surv = 1.0f;
        bf16x8_t kn[4]; v2u vn[2][2][2];
#define SB_LOAD(kt_) do { const bf16* kp_ = Kb + (size_t)(32 * (kt_) + ql) * 64 + 8 * hi; \
        _Pragma("unroll") for (int t = 0; t < 4; ++t) kn[t] = *(const bf16x8_t*)(kp_ + 16 * t); \
        _Pragma("unroll") for (int mb = 0; mb < 2; ++mb) { const v4u* vp_ = (const v4u*)(Vb + ((size_t)(kt_) * 2 + mb) * 1024 + lane * 16); const v4u x0 = vp_[0], x1 = vp_[1]; \
            vn[mb][0][0] = (v2u){x0.x, x0.y}; vn[mb][0][1] = (v2u){x0.z, x0.w}; vn[mb][1][0] = (v2u){x1.x, x1.y}; vn[mb][1][1] = (v2u){x1.z, x1.w}; } \
        if (32 * (kt_) + 16 >= L) { vn[0][1][0] = (v2u){0u, 0u}; vn[0][1][1] = (v2u){0u, 0u}; vn[1][1][0] = (v2u){0u, 0u}; vn[1][1][1] = (v2u){0u, 0u}; } } while (0)
        bf16x8_t km[4]; v2u vm[2][2][2];
        SB_LOAD(qb);
#define SB_SHIFT(KD, VD, KS, VS) do { _Pragma("unroll") for (int t = 0; t < 4; ++t) KD[t] = KS[t]; \
        _Pragma("unroll") for (int mb = 0; mb < 2; ++mb) _Pragma("unroll") for (int s = 0; s < 2; ++s) { VD[mb][s][0] = VS[mb][s][0]; VD[mb][s][1] = VS[mb][s][1]; } } while (0)
        SB_SHIFT(km, vm, kn, vn);
        if (qb > 0) SB_LOAD(qb - 1);
        for (int kt = qb; kt >= 0; --kt) {
            bf16x8_t kf[4]; v2u vf[2][2][2];
            SB_SHIFT(kf, vf, km, vm);
            SB_SHIFT(km, vm, kn, vn);
            if (kt > 1) SB_LOAD(kt - 2);
            f32x16 S;
#pragma unroll
            for (int r = 0; r < 16; ++r) S[r] = 0.f;
#pragma unroll
            for (int t = 0; t < 4; ++t) S = __builtin_amdgcn_mfma_f32_32x32x16_bf16(kf[t], qf[t], S, 0, 0, 0);
            const bool diag = (kt == qb);
            float om[16], be[16], w[16];
#pragma unroll
            for (int r = 0; r < 16; ++r) {
                const float z = S[r] * 0.125f; const int kl = 8 * (r >> 2) + 4 * hi + (r & 3);
                const bool vis = !diag || kl < ql;
                const float t = __expf(-fmaxf(z, -80.0f));
                const float b = __builtin_amdgcn_rcpf(1.0f + t);
                be[r] = vis ? b : 0.f; om[r] = vis ? t * b : 1.0f;
            }
            float gp = 1.0f;
#pragma unroll
            for (int g = 3; g >= 0; --g) {
                const float T = (om[4 * g] * om[4 * g + 1]) * (om[4 * g + 2] * om[4 * g + 3]);
                const float U = __shfl_xor(T, 32);
                const float a3 = surv * gp * (hi == 0 ? U : 1.0f), a2 = a3 * om[4 * g + 3], a1 = a2 * om[4 * g + 2], a0 = a1 * om[4 * g + 1];
                w[4 * g + 3] = be[4 * g + 3] * a3; w[4 * g + 2] = be[4 * g + 2] * a2; w[4 * g + 1] = be[4 * g + 1] * a1; w[4 * g] = be[4 * g] * a0;
                gp *= T * U;
            }
            surv *= gp;
#pragma unroll
            for (int s = 0; s < 2; ++s) {
                v4u pw; pw.x = pk2(w[8 * s], w[8 * s + 1]); pw.y = pk2(w[8 * s + 2], w[8 * s + 3]); pw.z = pk2(w[8 * s + 4], w[8 * s + 5]); pw.w = pk2(w[8 * s + 6], w[8 * s + 7]);
                const bf16x8_t wb = __builtin_bit_cast(bf16x8_t, pw);
                v4u a0v; a0v.x = vf[0][s][0].x; a0v.y = vf[0][s][0].y; a0v.z = vf[0][s][1].x; a0v.w = vf[0][s][1].y;
                v4u a1v; a1v.x = vf[1][s][0].x; a1v.y = vf[1][s][0].y; a1v.z = vf[1][s][1].x; a1v.w = vf[1][s][1].y;
                o0 = __builtin_amdgcn_mfma_f32_32x32x16_bf16(__builtin_bit_cast(bf16x8_t, a0v), wb, o0, 0, 0, 0);
                o1 = __builtin_amdgcn_mfma_f32_32x32x16_bf16(__builtin_bit_cast(bf16x8_t, a1v), wb, o1, 0, 0, 0);
            }
            if (__ballot(valid && surv >= 1.17549435e-38f) == 0ull) break;
        }
#undef SB_LOAD
#undef SB_SHIFT
        if (valid) {
            const int b = bh >> 4, h = bh & 15;
            bf16* op = O + ((size_t)b * L + tq) * D + h * 64 + 4 * hi;
#pragma unroll
            for (int g = 0; g < 4; ++g) {
                v2u w0; w0.x = pk2(o0[4 * g], o0[4 * g + 1]); w0.y = pk2(o0[4 * g + 2], o0[4 * g + 3]); *(v2u*)(op + 8 * g) = w0;
                v2u w1; w1.x = pk2(o1[4 * g], o1[4 * g + 1]); w1.y = pk2(o1[4 * g + 2], o1[4 * g + 3]); *(v2u*)(op + 32 + 8 * g) = w1;
            }
        }
    }
}

#ifndef GLA_CHUNKED
#define GLA_CHUNKED 1
#endif
__device__ __forceinline__ void gla_decay_phase(const float* GL, const float* Wg, const float* bg, float* A, int tid, int G) {
    const int k = tid; float wg[16];
#pragma unroll
    for (int j = 0; j < 16; ++j) wg[j] = Wg[j * 512 + k];
    const float bk = bg[k];
    for (int row0 = blockIdx.x * 4; row0 < M; row0 += G * 4) {
        f32x4 g[4][4];
#pragma unroll
        for (int u = 0; u < 4; ++u)
#pragma unroll
            for (int q = 0; q < 4; ++q) g[u][q] = *(const f32x4*)(GL + (size_t)(row0 + u) * 16 + 4 * q);
#pragma unroll
        for (int u = 0; u < 4; ++u) {
            float x = bk;
#pragma unroll
            for (int q = 0; q < 4; ++q) x += (g[u][q][0] * wg[4 * q] + g[u][q][1] * wg[4 * q + 1]) + (g[u][q][2] * wg[4 * q + 2] + g[u][q][3] * wg[4 * q + 3]);
            const float ls = fminf(x, 0.f) - __logf(1.0f + __expf(-fabsf(x)));
            A[(size_t)(row0 + u) * 512 + k] = GLA_CHUNKED ? ls * (1.0f / 16.0f) : __expf(ls * (1.0f / 16.0f));
        }
    }
}

__device__ __forceinline__ void gla_scan_phase(const bf16* P, const float* A, float* OG, LAS unsigned char* lds, int tid, int wave, int lane, int G) {
    LAS unsigned char* la = lds; LAS unsigned char* lk = lds + 32768; LAS unsigned char* lq = lds + 49152; LAS unsigned char* lv = lds + 65536; LAS float* lo = (LAS float*)(lds + 69632);
    const int ks = lane >> 2, vi = lane & 3, vcol = 4 * wave + vi;
    for (int unit = blockIdx.x; unit < 256; unit += G) {
        const int b = unit >> 5, h = (unit >> 3) & 3, vq = unit & 7;
        float S[8];
#pragma unroll
        for (int j = 0; j < 8; ++j) S[j] = 0.f;
        v4u ra[4], rk[2], rq[2], rv;
        const int NCH = (L + 63) / 64;
#define GLA_LOAD(c) do { const int n_ = min(64, L - 64 * (c)); const size_t m0_ = (size_t)b * L + 64 * (c); \
        _Pragma("unroll") for (int i = 0; i < 4; ++i) { const int p = tid + 512 * i, r = p >> 5, cc = p & 31; ra[i] = r < n_ ? *(const v4u*)(A + (m0_ + r) * 512 + 128 * h + 4 * cc) : (v4u){0u, 0u, 0u, 0u}; } \
        _Pragma("unroll") for (int i = 0; i < 2; ++i) { const int p = tid + 512 * i, r = p >> 4, cc = p & 15; \
            rk[i] = r < n_ ? *(const v4u*)(P + (m0_ + r) * 3072 + 512 + 128 * h + 8 * cc) : (v4u){0u, 0u, 0u, 0u}; rq[i] = r < n_ ? *(const v4u*)(P + (m0_ + r) * 3072 + 128 * h + 8 * cc) : (v4u){0u, 0u, 0u, 0u}; } \
        { const int r = tid >> 2, cc = tid & 3; rv = (tid < 256 && r < n_) ? *(const v4u*)(P + (m0_ + r) * 3072 + 1024 + 256 * h + 32 * vq + 8 * cc) : (v4u){0u, 0u, 0u, 0u}; } } while (0)
        GLA_LOAD(0);
        for (int c = 0; c < NCH; ++c) {
            const int n = min(64, L - 64 * c);
#pragma unroll
            for (int i = 0; i < 4; ++i) { const int p = tid + 512 * i; *(LAS v4u*)(la + p * 16) = ra[i]; }
#pragma unroll
            for (int i = 0; i < 2; ++i) { const int p = tid + 512 * i; *(LAS v4u*)(lk + p * 16) = rk[i]; *(LAS v4u*)(lq + p * 16) = rq[i]; }
            if (tid < 256) *(LAS v4u*)(lv + tid * 16) = rv;
            __syncthreads();
            if (c + 1 < NCH) GLA_LOAD(c + 1);
            for (int tt0 = 0; tt0 < n; tt0 += 4) {
                float ov[4];
#pragma unroll
                for (int u = 0; u < 4; ++u) {
                    const int tt = tt0 + u;
                    const f32x4 a0 = *(const LAS f32x4*)(la + tt * 512 + ks * 32), a1 = *(const LAS f32x4*)(la + tt * 512 + ks * 32 + 16);
                    const v4u kr = *(const LAS v4u*)(lk + tt * 256 + ks * 16), qr = *(const LAS v4u*)(lq + tt * 256 + ks * 16);
                    const float vv = __builtin_bit_cast(float, (unsigned)(*(const LAS unsigned short*)(lv + tt * 64 + vcol * 2)) << 16);
                    float o, o2;
                    S[0] = S[0] * a0[0] + bflo(kr.x) * vv; o  = bflo(qr.x) * S[0];
                    S[1] = S[1] * a0[1] + bfhi(kr.x) * vv; o2 = bfhi(qr.x) * S[1];
                    S[2] = S[2] * a0[2] + bflo(kr.y) * vv; o  += bflo(qr.y) * S[2];
                    S[3] = S[3] * a0[3] + bfhi(kr.y) * vv; o2 += bfhi(qr.y) * S[3];
                    S[4] = S[4] * a1[0] + bflo(kr.z) * vv; o  += bflo(qr.z) * S[4];
                    S[5] = S[5] * a1[1] + bfhi(kr.z) * vv; o2 += bfhi(qr.z) * S[5];
                    S[6] = S[6] * a1[2] + bflo(kr.w) * vv; o  += bflo(qr.w) * S[6];
                    S[7] = S[7] * a1[3] + bfhi(kr.w) * vv; o2 += bfhi(qr.w) * S[7];
                    ov[u] = o + o2;
                }
#pragma unroll
                for (int u = 0; u < 4; ++u) {
                    const int x = __builtin_bit_cast(int, ov[u]);
                    const float r4 = __builtin_bit_cast(float, __builtin_amdgcn_update_dpp(0, x, 0x124, 0xf, 0xf, false));
                    const float r8 = __builtin_bit_cast(float, __builtin_amdgcn_update_dpp(0, x, 0x128, 0xf, 0xf, false));
                    const float r12 = __builtin_bit_cast(float, __builtin_amdgcn_update_dpp(0, x, 0x12C, 0xf, 0xf, false));
                    ov[u] = (ov[u] + r4) + (r8 + r12);
                }
                if ((lane & 12) == 0) {
#pragma unroll
                    for (int u = 0; u < 4; ++u) lo[((tt0 + u) * 4 + (lane >> 4)) * 32 + vcol] = ov[u] * 0.08838834764831845f;
                }
            }
            __syncthreads();
            const size_t m0 = (size_t)b * L + 64 * c;
#pragma unroll
            for (int i = 0; i < 4; ++i) { const int idx = tid + 512 * i, r = idx >> 5, cc = idx & 31; if (r < n) OG[(m0 + r) * 1024 + 256 * h + 32 * vq + cc] = (lo[(r * 4 + 0) * 32 + cc] + lo[(r * 4 + 1) * 32 + cc]) + (lo[(r * 4 + 2) * 32 + cc] + lo[(r * 4 + 3) * 32 + cc]); }
        }
#undef GLA_LOAD
        __syncthreads();
    }
}


constexpr int GLA_NCH = 33, GLA_UNITS = NB * GLA_NCH * 4;
constexpr size_t WS_GQD = 244 * MiB, WS_GKST = 3 * MiB, WS_GATT = 376 * MiB, WS_GDEC = 385 * MiB, WS_GVT = 343 * MiB;
__device__ __forceinline__ void gla_pre_phase(const bf16* P, const float* GL, const float* Wg, const float* bg, bf16* QDP, bf16* KST, bf16* ATT, bf16* VT2, float* DEC, LAS unsigned char* lds, int tid, int wave, int lane, int G) {
    LAS float* Bm = (LAS float*)lds;
    LAS unsigned short* QDl = (LAS unsigned short*)(lds + 32768);
    LAS unsigned short* KDl = (LAS unsigned short*)(lds + 49152);
    LAS unsigned short* KSl = (LAS unsigned short*)(lds + 65536);
    LAS unsigned short* VTl = (LAS unsigned short*)(lds + 81920);
    LAS float* TOT = (LAS float*)(lds + 114688);
    LAS float* GLs = (LAS float*)(lds + 116736);
    for (int u = blockIdx.x; u < GLA_UNITS; u += G) {
        const int h = u & 3, bn = u >> 2, n = bn % GLA_NCH, b = bn / GLA_NCH;
        const int t0 = 64 * n - 48;
        v4u pq0 = (v4u){0u, 0u, 0u, 0u}, pq1 = pq0, pk0 = pq0, pk1 = pq0;
        { const int t = t0 + (tid >> 3); if (t >= 0) { const bf16* pr = P + ((size_t)b * L + t) * 3072 + 128 * h + 16 * (tid & 7); pq0 = *(const v4u*)pr; pq1 = *(const v4u*)(pr + 8); pk0 = *(const v4u*)(pr + 512); pk1 = *(const v4u*)(pr + 520); } }
#pragma unroll
        for (int i = 0; i < 4; ++i) {
            const int p = tid + 512 * i, r = p >> 5, cc = p & 31, t = t0 + r;
            v4u vv = (v4u){0u, 0u, 0u, 0u};
            if (t >= 0) vv = *(const v4u*)(P + ((size_t)b * L + t) * 3072 + 1024 + 256 * h + 8 * cc);
            LAS unsigned short* vp = VTl + (8 * cc) * 64 + (r ^ (8 * (cc & 7)));
            vp[0] = (unsigned short)(vv.x & 0xffffu); vp[64] = (unsigned short)(vv.x >> 16); vp[128] = (unsigned short)(vv.y & 0xffffu); vp[192] = (unsigned short)(vv.y >> 16);
            vp[256] = (unsigned short)(vv.z & 0xffffu); vp[320] = (unsigned short)(vv.z >> 16); vp[384] = (unsigned short)(vv.w & 0xffffu); vp[448] = (unsigned short)(vv.w >> 16);
        }
        if (tid < 256) { const int r = tid >> 2, cc = tid & 3, t = t0 + r;
            *(LAS f32x4*)(GLs + r * 16 + 4 * cc) = t >= 0 ? *(const f32x4*)(GL + ((size_t)b * L + t) * 16 + 4 * cc) : (f32x4){0.f, 0.f, 0.f, 0.f}; }
        __syncthreads();
        { const int k = tid & 127, seg = tid >> 7; float run = 0.f;
          float wg[16];
#pragma unroll
          for (int j2 = 0; j2 < 16; ++j2) wg[j2] = Wg[j2 * 512 + 128 * h + k];
          const float bk = bg[128 * h + k];
#pragma unroll 4
          for (int i = 0; i < 16; ++i) {
              const int row = 16 * seg + i; const LAS f32x4* gr = (const LAS f32x4*)(GLs + row * 16);
              const f32x4 g0 = gr[0], g1 = gr[1], g2 = gr[2], g3 = gr[3];
              float x = bk + (g0[0] * wg[0] + g0[1] * wg[1]) + (g0[2] * wg[2] + g0[3] * wg[3]) + (g1[0] * wg[4] + g1[1] * wg[5]) + (g1[2] * wg[6] + g1[3] * wg[7])
                           + (g2[0] * wg[8] + g2[1] * wg[9]) + (g2[2] * wg[10] + g2[3] * wg[11]) + (g3[0] * wg[12] + g3[1] * wg[13]) + (g3[2] * wg[14] + g3[3] * wg[15]);
              const float ls = fminf(x, 0.f) - __logf(1.0f + __expf(-fabsf(x)));
              run += (t0 + row >= 0) ? ls * (1.0f / 16.0f) : 0.f; Bm[row * 128 + k] = run;
          }
          TOT[seg * 128 + k] = run; }
        __syncthreads();
        { const int k = tid & 127, seg = tid >> 7; float pre = 0.f;
          for (int s = 0; s < seg; ++s) pre += TOT[s * 128 + k];
          if (seg) {
#pragma unroll
              for (int i = 0; i < 16; ++i) Bm[(16 * seg + i) * 128 + k] += pre; } }
        __syncthreads();
        { const int c = tid >> 3, sg = tid & 7, t = t0 + c;
          const v4u q0 = pq0, q1 = pq1, k0 = pk0, k1 = pk1;
          const unsigned qw[8] = {q0.x, q0.y, q0.z, q0.w, q1.x, q1.y, q1.z, q1.w}, kw[8] = {k0.x, k0.y, k0.z, k0.w, k1.x, k1.y, k1.z, k1.w};
          float qd[16], kd[16];
#pragma unroll
          for (int e = 0; e < 16; ++e) {
              const float bb = Bm[c * 128 + 16 * sg + e], bl = Bm[63 * 128 + 16 * sg + e];
              const float qv = (e & 1) ? bfhi(qw[e >> 1]) : bflo(qw[e >> 1]), kv = (e & 1) ? bfhi(kw[e >> 1]) : bflo(kw[e >> 1]);
              qd[e] = qv * 0.08838834764831845f * __expf(bb); kd[e] = kv * __expf(-bb);
              KSl[(16 * sg + e) * 64 + (c ^ (8 * sg))] = (unsigned short)f2bf(kv * __expf(bl - bb));
          }
          v4u a0, a1, b0, b1;
          a0.x = pk2(qd[0], qd[1]); a0.y = pk2(qd[2], qd[3]); a0.z = pk2(qd[8], qd[9]); a0.w = pk2(qd[10], qd[11]);
          a1.x = pk2(qd[4], qd[5]); a1.y = pk2(qd[6], qd[7]); a1.z = pk2(qd[12], qd[13]); a1.w = pk2(qd[14], qd[15]);
          b0.x = pk2(kd[0], kd[1]); b0.y = pk2(kd[2], kd[3]); b0.z = pk2(kd[8], kd[9]); b0.w = pk2(kd[10], kd[11]);
          b1.x = pk2(kd[4], kd[5]); b1.y = pk2(kd[6], kd[7]); b1.z = pk2(kd[12], kd[13]); b1.w = pk2(kd[14], kd[15]);
          *(LAS v4u*)(QDl + c * 128 + 16 * sg) = a0; *(LAS v4u*)(QDl + c * 128 + 16 * sg + 8) = a1;
          *(LAS v4u*)(KDl + c * 128 + 16 * sg) = b0; *(LAS v4u*)(KDl + c * 128 + 16 * sg + 8) = b1;
          bf16* gq = QDP + (size_t)u * 8192 + c * 128 + 16 * sg; *(v4u*)gq = a0; *(v4u*)(gq + 8) = a1;
        }
        if (tid < 128) DEC[(size_t)u * 128 + tid] = __expf(Bm[63 * 128 + tid]);
        __syncthreads();
        if (wave < 4) {
            const int mb = wave >> 1, nb = wave & 1, ql = lane & 31, hi = lane >> 5;
            f32x16 acc;
#pragma unroll
            for (int r = 0; r < 16; ++r) acc[r] = 0.f;
#pragma unroll
            for (int st = 0; st < 8; ++st) {
                const bf16x8_t a = *(const LAS bf16x8_t*)(QDl + (32 * mb + ql) * 128 + 16 * st + 8 * hi), bq = *(const LAS bf16x8_t*)(KDl + (32 * nb + ql) * 128 + 16 * st + 8 * hi);
                acc = __builtin_amdgcn_mfma_f32_32x32x16_bf16(a, bq, acc, 0, 0, 0);
            }
            bf16* ap = ATT + (size_t)u * 4096 + 32 * nb + ql;
#pragma unroll
            for (int r = 0; r < 16; ++r) { const int c = 32 * mb + 8 * (r >> 2) + 4 * hi + (r & 3), s = 32 * nb + ql; ap[c * 64] = (bf16)f2bf(s <= c ? acc[r] : 0.f); }
        }
#pragma unroll
        for (int i = 0; i < 2; ++i) { const int p = tid + 512 * i, kk = p >> 3, ch = p & 7; *(v4u*)(KST + (size_t)u * 8192 + p * 8) = *(const LAS v4u*)(KSl + kk * 64 + 8 * (ch ^ ((kk >> 4) & 7))); }
#pragma unroll
        for (int i = 0; i < 4; ++i) { const int p = tid + 512 * i, vv2 = p >> 3, ch = p & 7; *(v4u*)(VT2 + (size_t)u * 16384 + p * 8) = *(const LAS v4u*)(VTl + vv2 * 64 + 8 * (ch ^ ((vv2 >> 3) & 7))); }
        __syncthreads();
    }
}

__device__ __forceinline__ bf16x8_t gla_pack(const f32x16& x, int half) {
    v4u p; p.x = pk2(x[8 * half], x[8 * half + 1]); p.y = pk2(x[8 * half + 2], x[8 * half + 3]); p.z = pk2(x[8 * half + 4], x[8 * half + 5]); p.w = pk2(x[8 * half + 6], x[8 * half + 7]);
    return __builtin_bit_cast(bf16x8_t, p);
}
__device__ __forceinline__ void gla_seq_phase(const bf16* QDP, const bf16* KST, const bf16* ATT, const bf16* VT2, const float* DEC, float* OG, LAS unsigned char* lds, int tid, int wave, int lane, int G) {
    volatile LAS unsigned* flags = (volatile LAS unsigned*)(lds + 16384);
    if (tid < 4) flags[tid] = 0u;
    __syncthreads();
    const int unit = blockIdx.x;
    if (wave >= 3 || unit >= 256) return;
    const int ql = lane & 31, hi = lane >> 5;
    const int xcd = unit & 7, idx = unit >> 3, bhx = xcd * 4 + (idx >> 3);
    const int b = bhx >> 2, h = bhx & 3, vs = idx & 7;
    const size_t u0 = (size_t)(b * GLA_NCH) * 4 + h;
    const bf16* vtb = VT2 + u0 * 16384 + (size_t)(32 * vs + ql) * 64 + 8 * hi;
#define GLA_SPIN(cond) do { unsigned sp_ = 0; while ((cond) && ++sp_ < (1u << 22)) __builtin_amdgcn_s_sleep(1); } while (0)
    if (wave == 0) {
        const bf16* ksb = KST + u0 * 8192 + ql * 64 + 8 * hi; const float* decb = DEC + u0 * 128 + 4 * hi;
        f32x16 S0, S1, S2, S3;
#pragma unroll
        for (int r = 0; r < 16; ++r) { S0[r] = 0.f; S1[r] = 0.f; S2[r] = 0.f; S3[r] = 0.f; }
        bf16x8_t vf[4], k0[4], k1[4], k2[4], k3[4]; f32x4 d0[4], d1[4], d2[4], d3[4];
#pragma unroll
        for (int st = 0; st < 4; ++st) { vf[st] = *(const bf16x8_t*)(vtb + 16 * st); k0[st] = *(const bf16x8_t*)(ksb + 16 * st); k1[st] = *(const bf16x8_t*)(ksb + 2048 + 16 * st);
            k2[st] = *(const bf16x8_t*)(ksb + 4096 + 16 * st); k3[st] = *(const bf16x8_t*)(ksb + 6144 + 16 * st);
            d0[st] = *(const f32x4*)(decb + 8 * st); d1[st] = *(const f32x4*)(decb + 32 + 8 * st); d2[st] = *(const f32x4*)(decb + 64 + 8 * st); d3[st] = *(const f32x4*)(decb + 96 + 8 * st); }
        for (int n = 0; n < GLA_NCH; ++n) {
            if (n >= 2) { GLA_SPIN(flags[1] < (unsigned)(n - 1) || flags[2] < (unsigned)(n - 1)); }
            LAS unsigned char* slot = lds + (n & 1) * 8192 + lane * 16;
            *(LAS bf16x8_t*)(slot + 0 * 1024) = gla_pack(S0, 0); *(LAS bf16x8_t*)(slot + 1 * 1024) = gla_pack(S0, 1); *(LAS bf16x8_t*)(slot + 2 * 1024) = gla_pack(S1, 0); *(LAS bf16x8_t*)(slot + 3 * 1024) = gla_pack(S1, 1);
            *(LAS bf16x8_t*)(slot + 4 * 1024) = gla_pack(S2, 0); *(LAS bf16x8_t*)(slot + 5 * 1024) = gla_pack(S2, 1); *(LAS bf16x8_t*)(slot + 6 * 1024) = gla_pack(S3, 0); *(LAS bf16x8_t*)(slot + 7 * 1024) = gla_pack(S3, 1);
            __builtin_amdgcn_fence(__ATOMIC_RELEASE, "workgroup");
            if (lane == 0) flags[0] = (unsigned)(n + 1);
            const int nn = n + 1 < GLA_NCH ? n + 1 : n;
            const bf16* ksn = ksb + (size_t)nn * 4 * 8192; const float* decn = decb + (size_t)nn * 4 * 128; const bf16* vtn = vtb + (size_t)nn * 4 * 16384;
#define GLA_SUPD(SX, KX, DX, kb) do { _Pragma("unroll") for (int g = 0; g < 4; ++g) { SX[4 * g] *= DX[g][0]; SX[4 * g + 1] *= DX[g][1]; SX[4 * g + 2] *= DX[g][2]; SX[4 * g + 3] *= DX[g][3]; } \
                _Pragma("unroll") for (int g = 0; g < 4; ++g) DX[g] = *(const f32x4*)(decn + 32 * (kb) + 8 * g); \
                _Pragma("unroll") for (int st = 0; st < 4; ++st) SX = __builtin_amdgcn_mfma_f32_32x32x16_bf16(KX[st], vf[st], SX, 0, 0, 0); \
                _Pragma("unroll") for (int st = 0; st < 4; ++st) KX[st] = *(const bf16x8_t*)(ksn + (kb) * 2048 + 16 * st); } while (0)
            GLA_SUPD(S0, k0, d0, 0); GLA_SUPD(S1, k1, d1, 1); GLA_SUPD(S2, k2, d2, 2); GLA_SUPD(S3, k3, d3, 3);
#undef GLA_SUPD
#pragma unroll
            for (int st = 0; st < 4; ++st) vf[st] = *(const bf16x8_t*)(vtn + 16 * st);
        }
    } else {
        const int mb = wave - 1;
        const bf16* attb = ATT + u0 * 4096 + (size_t)(32 * mb + ql) * 64 + 8 * hi; const bf16* qdb = QDP + u0 * 8192 + (size_t)(32 * mb + ql) * 128 + 8 * hi;
        bf16x8_t vf[4], af[4], qf[8];
#pragma unroll
        for (int st = 0; st < 4; ++st) { vf[st] = *(const bf16x8_t*)(vtb + 16 * st); af[st] = *(const bf16x8_t*)(attb + 16 * st); }
#pragma unroll
        for (int st = 0; st < 8; ++st) qf[st] = *(const bf16x8_t*)(qdb + 16 * st);
        for (int n = 0; n < GLA_NCH; ++n) {
            const int nn = n + 1 < GLA_NCH ? n + 1 : n;
            f32x16 o;
#pragma unroll
            for (int r = 0; r < 16; ++r) o[r] = 0.f;
#pragma unroll
            for (int st = 0; st < 4; ++st) o = __builtin_amdgcn_mfma_f32_32x32x16_bf16(af[st], vf[st], o, 0, 0, 0);
#pragma unroll
            for (int st = 0; st < 4; ++st) { af[st] = *(const bf16x8_t*)(attb + (size_t)nn * 4 * 4096 + 16 * st); vf[st] = *(const bf16x8_t*)(vtb + (size_t)nn * 4 * 16384 + 16 * st); }
            GLA_SPIN(flags[0] < (unsigned)(n + 1));
            __builtin_amdgcn_fence(__ATOMIC_ACQUIRE, "workgroup");
            const LAS unsigned char* slot = lds + (n & 1) * 8192 + lane * 16;
            bf16x8_t sb[8];
#pragma unroll
            for (int st = 0; st < 8; ++st) sb[st] = *(const LAS bf16x8_t*)(slot + st * 1024);
            asm volatile("s_waitcnt lgkmcnt(0)" ::: "memory");
            if (lane == 0) flags[wave] = (unsigned)(n + 1);
#pragma unroll
            for (int st = 0; st < 8; ++st) o = __builtin_amdgcn_mfma_f32_32x32x16_bf16(qf[st], sb[st], o, 0, 0, 0);
#pragma unroll
            for (int st = 0; st < 8; ++st) qf[st] = *(const bf16x8_t*)(qdb + (size_t)nn * 4 * 8192 + 16 * st);
#pragma unroll
            for (int r = 0; r < 16; ++r) { const int t = 64 * n - 48 + 32 * mb + 8 * (r >> 2) + 4 * hi + (r & 3); if (t >= 0) ((bf16*)OG)[((size_t)b * L + t) * 1024 + 256 * h + 32 * vs + ql] = (bf16)f2bf(o[r]); }
        }
    }
#undef GLA_SPIN
}

__device__ __forceinline__ void gla_gate_phase(const float* OG, const bf16* P, const float* gout, bf16* GA, int gw, int NGW, int lane) {
    for (int row = gw; row < M; row += NGW) {
#pragma unroll
        for (int j = 0; j < 4; ++j) {
            const v2u ow = *((const v2u*)((const bf16*)OG + (size_t)row * 1024 + 256 * j) + lane); const f32x4 o = (f32x4){bflo(ow.x), bfhi(ow.x), bflo(ow.y), bfhi(ow.y)};
            const float ss = wave_sum((o[0] * o[0] + o[1] * o[1]) + (o[2] * o[2] + o[3] * o[3]));
            const float r = __builtin_amdgcn_rsqf(ss * (1.0f / 256.0f) + 1e-6f);
            const f32x4 g = *((const f32x4*)(gout + 256 * j) + lane);
            const v2u rr = *((const v2u*)(P + (size_t)row * 3072 + 2048 + 256 * j) + lane);
            const float r0 = bflo(rr.x), r1 = bfhi(rr.x), r2 = bflo(rr.y), r3 = bfhi(rr.y);
            const float y0 = o[0] * r * g[0] * pg8::silu_f(r0), y1 = o[1] * r * g[1] * pg8::silu_f(r1), y2 = o[2] * r * g[2] * pg8::silu_f(r2), y3 = o[3] * r * g[3] * pg8::silu_f(r3);
            v2u w; w.x = pk2(y0, y1); w.y = pk2(y2, y3);
            *((v2u*)(GA + (size_t)row * 1024 + 256 * j) + lane) = w;
        }
    }
}

template <class Epi> __device__ __forceinline__ void run_gemm(LAS unsigned char* lds, const bf16* A, const bf16* Bt, int N, int K, const Epi& E, int G) {
    pg8::Gemm g{A, Bt, MP, N, K}; pg8::StaticOrder S; S.init(MP, N, G, (int)blockIdx.x, K / 64);
    pg8::gemm_phase<Epi, pg8::StaticOrder, true, true>((PG8_LAS unsigned char*)lds, g, S, E);
}
template <class Epi> __device__ __forceinline__ void run_gemm_split(LAS unsigned char* lds, const bf16* A, const bf16* Bt, int K, int nsplit, const Epi& E, int G) {
    pg8::Gemm g{A, Bt, MP, 1024, K}; pg8::SplitTailOrder S; S.init(G, (int)blockIdx.x, K / 64, nsplit);
    pg8::gemm_phase<Epi, pg8::SplitTailOrder, true, true>((PG8_LAS unsigned char*)lds, g, S, E);
}
template <bool FINAL> __device__ __forceinline__ void tail_finalize(const float* SLAB, int nsplit, float* Hp, bf16* HBp, float* SSp, float* OUT, float wres, int gw, int lane) {
    if (gw >= M - 64 * 256) return;
    const int row = 64 * 256 + gw;
    f32x4 a[4];
#pragma unroll
    for (int j = 0; j < 4; ++j) a[j] = (f32x4){0.f, 0.f, 0.f, 0.f};
    for (int s = 0; s < nsplit; ++s)
#pragma unroll
        for (int j = 0; j < 4; ++j) a[j] += *((const f32x4*)(SLAB + ((size_t)s * 256 + gw) * 1024 + 256 * j) + lane);
    float ss = 0.f;
    const int bb = row / L, tt = row - bb * L;
#pragma unroll
    for (int j = 0; j < 4; ++j) {
        v2u* hbp = (v2u*)(HBp + (size_t)row * D + 256 * j) + lane;
        const v2u hw = *hbp;
        const f32x4 hv = (f32x4){bflo(hw.x), bfhi(hw.x), bflo(hw.y), bfhi(hw.y)};
        const f32x4 v = hv + a[j] * wres;
        if (FINAL) { if (tt >= NMETA) *((f32x4*)(OUT + ((size_t)bb * SEQ + (tt - NMETA)) * D + 256 * j) + lane) = v; }
        else { v2u w; w.x = pk2(v[0], v[1]); w.y = pk2(v[2], v[3]); *hbp = w;
               const float r0 = bflo(w.x), r1 = bfhi(w.x), r2 = bflo(w.y), r3 = bfhi(w.y); ss += (r0 * r0 + r1 * r1) + (r2 * r2 + r3 * r3); }
    }
    if (!FINAL) { ss = wave_sum(ss); if (lane < 16) SSp[(size_t)row * 16 + lane] = lane == 0 ? ss : 0.f; }
}

#ifndef SB_NAIVE
#define SB_ATTN_FN sb_attn_mfma
#define SB_VT_PITCH SB_LP
#else
#define SB_ATTN_FN sb_attn_phase
#define SB_VT_PITCH 0
#endif
#ifndef REP_SB
#define REP_SB 1
#endif
#ifndef REP_GU
#define REP_GU 1
#endif
#ifndef REP_MIX
#define REP_MIX 1
#endif
#ifndef REP_DOWN
#define REP_DOWN 1
#endif
#ifndef REP_OUT
#define REP_OUT 1
#endif
#ifndef REP_PRE
#define REP_PRE 1
#endif
#ifndef REP_CONV
#define REP_CONV 1
#endif
#ifndef REP_GATE
#define REP_GATE 1
#endif
#ifndef REP_SCAN
#define REP_SCAN 1
#endif
#ifndef REP_SYNC
#define REP_SYNC 0
#endif
__global__ void __launch_bounds__(NTHR, 2) fwd_megakernel(Args args) {
    extern __shared__ __attribute__((aligned(16))) unsigned char lds_raw[];
    LAS unsigned char* lds = (LAS unsigned char*)lds_raw;
    cg::grid_group grid = cg::this_grid();
    volatile LAS unsigned* MISC = (volatile LAS unsigned*)(lds + 131072 + 320);
    if (threadIdx.x < 32) MISC[threadIdx.x] = 0u;
    __syncthreads();
    if (blockIdx.x == 0) { unsigned* ctl = (unsigned*)(KWS + WS_CTL); for (int i = threadIdx.x; i < XCD_BAR_WORDS; i += NTHR) ctl[CW_BAR + i] = 0u; if (threadIdx.x < 128) ctl[CW_CNT + threadIdx.x] = 0u; }
    XcdBarrier bar; bar.bar = (unsigned*)(KWS + WS_CTL) + CW_BAR; bar.x = 0; bar.st = MISC + 8;
#ifdef USE_CG_SYNC
#define GRID_BAR() grid.sync()
#else
#define GRID_BAR() xcd_barrier(bar)
#endif
    const int wave = __builtin_amdgcn_readfirstlane(threadIdx.x >> 6);
    const int G = gridDim.x, gw = blockIdx.x * NWAVES + wave, NGW = G * NWAVES, GT = G * NTHR;
#define FRESH_TID() ({ int t_ = threadIdx.x; asm volatile("" : "+v"(t_)); t_; })
#define ws KWS
#define H ((float*)(ws + WS_H))
#define HB ((bf16*)(ws + WS_HB))
#define SS ((float*)(ws + WS_SS))
#define ACT ((bf16*)(ws + WS_ACT))

#define RES_GEMM(FIN, Aptr, Wptr, KK, NS, WR, GI) do { \
        pg8::EpiRes E{H, HB, SS, KOUT, WR, (float*)(ws + WS_SLAB), (unsigned*)(ws + WS_CTL) + CW_CNT + 4 * (GI), lds + 131072 + 1024, FIN, NS}; run_gemm_split(lds, Aptr, Wptr, KK, NS, E, G); } while (0)
    { const int tid = FRESH_TID(); prologue_rows(args, ws, gw, NGW, tid & 63); }
    enum { PH_CONV = 0, PH_GU = 1, PH_DOWN = 2, PH_QKV = 3, PH_ATTN = 4, PH_OUT = 5, PH_IN = 6, PH_PRE = 7, PH_SEQ = 8, PH_GATE = 9 };
#pragma unroll 1
    for (int layer = 0; layer < DEPTH; ++layer) {
        const int j = layer >> 1; const bool sb = (layer & 1) == 0; const int np = sb ? 8 : 10;
#pragma unroll 1
        for (int p = 0; p < np; ++p) {
            const int ab = p >= np - 2;
            const int kind = p == 0 ? PH_CONV : (p == 1 || p == np - 2) ? PH_GU : (p == 2 || p == np - 1) ? PH_DOWN : sb ? p : (p == 7 ? PH_OUT : p + 3);
            const bool fin = (layer == DEPTH - 1 && p == np - 1);
            switch (kind) {
            case PH_CONV: if (layer == 0) { const int tid = FRESH_TID(); conv_phase(args, ws, 0, 5, lds, gw, NGW, wave, tid & 63, blockIdx.x * NTHR + tid, GT); } break;
            case PH_GU: case PH_QKV: case PH_IN: {
                const int ek = kind == PH_GU ? 0 : kind == PH_QKV ? 1 : 2;
                const bf16* Wp = (const bf16*)(ws + (ek == 0 ? (ab ? WS_WGUB : WS_WGUA) : WS_WMIX)); const int NN = ek == 0 ? 2 * FF : ek == 1 ? 3 * D : GLA_INP;
                for (int rep = 0; rep < REP_GU; ++rep) {
                    pg8::EpiAny E{ek, pg8::EpiGU{ACT, SS}, pg8::EpiQKV{(bf16*)(ws + WS_Q), (size_t)(WS_K - WS_Q) / 2, SS, KIN(7) + j * 64, KIN(8) + j * 64, SB_VT_PITCH}, pg8::EpiGLAIn{(bf16*)(ws + WS_GP), (float*)(ws + WS_GGL), SS}};
                    run_gemm(lds, HB, Wp, NN, D, E, G); }
                {
                    const int idle0 = ek == 0 ? 150 : ek == 1 ? 12 : 77;
                    if ((int)blockIdx.x >= idle0) { const int tid = FRESH_TID(); const int b0 = (int)blockIdx.x - idle0, nb = G - idle0;
                        int p0 = -1, l0 = 0, p1 = -1, l1 = 0;
                        if (ek == 0 && !ab && layer == 0) { p0 = 3; l0 = 0; }
                        if (ek == 0 && ab && layer + 1 < DEPTH) { p0 = 3; l0 = layer + 1; }
                        if (ek == 1) { p0 = 1; l0 = layer; }
                        if (ek != 0 && layer + 1 < DEPTH) { p1 = 2; l1 = layer + 1; }
#pragma unroll 1
                        for (int q = 0; q < 2; ++q) { const int pp = q ? p1 : p0, ll = q ? l1 : l0; if (pp >= 0) conv_phase(args, ws, ll, pp, lds, b0 * NWAVES + wave, nb * NWAVES, wave, tid & 63, b0 * NTHR + tid, nb * NTHR); }
                    } }
                } break;
            case PH_DOWN: case PH_OUT: {
                const bool dn = kind == PH_DOWN;
                const bf16* Ap = dn ? ACT : (const bf16*)(ws + (sb ? WS_O : WS_GGA)); const bf16* Wp = (const bf16*)(ws + (dn ? (ab ? WS_WDB : WS_WDA) : WS_WO));
                const int KK = dn ? FF : D, ns = dn ? 11 : 4, gi = dn ? layer * 3 + 2 * ab : layer * 3 + 1; const float wr_ = dn ? 0.5f : 1.0f;
                pg8::EpiRes E{H, HB, SS, KOUT, wr_, (float*)(ws + WS_SLAB), (unsigned*)(ws + WS_CTL) + CW_CNT + 4 * gi, lds + 131072 + 1024, fin ? 1 : 0, ns}; run_gemm_split(lds, Ap, Wp, KK, ns, E, G); } break;
            case PH_ATTN: for (int rep = 0; rep < REP_SB; ++rep) { const int tid = FRESH_TID(); SB_ATTN_FN((const bf16*)(ws + WS_Q), (const bf16*)(ws + WS_K), (const bf16*)(ws + WS_V), (bf16*)(ws + WS_O), gw, NGW, tid & 63); } break;
            case PH_PRE: { const int tid = FRESH_TID(); gla_pre_phase((const bf16*)(ws + WS_GP), (const float*)(ws + WS_GGL), KIN(11) + (size_t)j * 16 * 512, KIN(12) + j * 512, (bf16*)(ws + WS_GQD), (bf16*)(ws + WS_GKST), (bf16*)(ws + WS_GATT), (bf16*)(ws + WS_GVT), (float*)(ws + WS_GDEC), lds, tid, wave, tid & 63, G); } break;
            case PH_SEQ: { const int tid = FRESH_TID(); gla_seq_phase((const bf16*)(ws + WS_GQD), (const bf16*)(ws + WS_GKST), (const bf16*)(ws + WS_GATT), (const bf16*)(ws + WS_GVT), (const float*)(ws + WS_GDEC), (float*)(ws + WS_GOG), lds, tid, wave, tid & 63, G); }
                if (wave >= 3) { const int tid = FRESH_TID(); conv_phase(args, ws, layer, 1, lds, blockIdx.x * 5 + (wave - 3), G * 5, wave, tid & 63, 0, 1); } break;
            default: for (int rep = 0; rep < REP_GATE; ++rep) { const int tid = FRESH_TID(); gla_gate_phase((const float*)(ws + WS_GOG), (const bf16*)(ws + WS_GP), KIN(13) + j * 1024, (bf16*)(ws + WS_GGA), gw, NGW, tid & 63); } break;
            }
            if (fin) break;
            if (kind == PH_CONV && layer > 0) continue;
            if (layer == 0 && p == 0) { grid.sync(); bar = xcd_barrier_post((unsigned*)(KWS + WS_CTL) + CW_BAR, MISC + 8); } else GRID_BAR();
        }
    }
}
#undef ws
#undef H
#undef HB
#undef SS
#undef ACT

extern "C" void kernel_launch(void* const* d_in, const int* in_sizes, int n_in, void* d_out, int out_size, void* d_ws, size_t ws_size, hipStream_t stream) {
    static int grid = 0;
    if (grid == 0) {
        if (n_in != 18 || ws_size < WS_END) { fprintf(stderr, "kernel_launch: expected 18 inputs and >= %zu bytes of workspace (got %d, %zu)\n", (size_t)WS_END, n_in, ws_size); grid = -1; return; }
        int dev = 0, cus = 0, per_cu = 0;
        hipGetDevice(&dev); hipDeviceGetAttribute(&cus, hipDeviceAttributeMultiprocessorCount, dev);
        if (hipFuncSetAttribute((const void*)fwd_megakernel, hipFuncAttributeMaxDynamicSharedMemorySize, LDS_BYTES) != hipSuccess) { fprintf(stderr, "kernel_launch: hipFuncSetAttribute failed\n"); grid = -1; return; }
        if (hipOccupancyMaxActiveBlocksPerMultiprocessor(&per_cu, (const void*)fwd_megakernel, NTHR, LDS_BYTES) != hipSuccess || per_cu < 1) { fprintf(stderr, "kernel_launch: occupancy query failed (%d)\n", per_cu); per_cu = 1; }
        (void)hipGetLastError();
        if (cus != 256) { fprintf(stderr, "kernel_launch: built for a 256-CU device (got %d)\n", cus); grid = -1; return; }
        grid = cus * 1;
    }
    if (grid < 0) return;
    Args a{};
    for (int i = 0; i < 18; ++i) a.in[i] = (const float*)d_in[i];
    a.out = (float*)d_out; a.ws = (unsigned char*)d_ws;
    void* kargs[] = {&a};
    hipError_t e = hipLaunchCooperativeKernel((const void*)fwd_megakernel, dim3(grid), dim3(NTHR), kargs, LDS_BYTES, stream);
    if (e != hipSuccess) fprintf(stderr, "kernel_launch: cooperative launch failed: %s (grid %d)\n", hipGetErrorString(e), grid);
}
```

```cpp
#include <hip/hip_runtime.h>
#include <hip/hip_cooperative_groups.h>
#include <cstdio>
#include <cstdint>

namespace pg8 {
#define PG8_LAS __attribute__((address_space(3)))
typedef unsigned short bf16_t;
typedef short bf16x8 __attribute__((ext_vector_type(8)));
typedef float f32x4 __attribute__((ext_vector_type(4)));
typedef unsigned u32x4 __attribute__((ext_vector_type(4)));
constexpr int BM = 256, BK = 64, HALF = 128, HTB = HALF * BK * 2  , STAGE_BYTES = 8 * HTB, NXCD = 8, WGM = 4;

__host__ __device__ __forceinline__ int lds_byte(int r, int c) { const int st = (r >> 4) * 2 + (c >> 5), rr = r & 15, cc = c & 31, ob = rr * 64 + cc * 2; return st * 1024 + (ob ^ (((ob >> 9) & 1) << 5)); }
__host__ __device__ __forceinline__ void stage_rc(int b, int& R, int& C) { const int st = b / 1024, sb = b % 1024, swz = sb ^ (((sb >> 9) & 1) << 5); R = (st >> 1) * 16 + swz / 64; C = (st & 1) * 32 + (swz % 64) / 2; }
__host__ __device__ __forceinline__ int perm32(int rho) { const int n = rho >> 4, i = rho & 15; return 8 * (i >> 2) + 4 * n + (i & 3); }

struct Unit { int pm, pn, kt0, nt; };
struct Gemm { const bf16_t* A; const bf16_t* Bt; int M, N, K; };

struct StaticOrder {
    int nM, nN, nwg, G, c, ntf;
    __host__ __device__ void init(int M, int N, int G_, int c_, int ntf_) { nM = M / BM; nN = N / BM; nwg = nM * nN; G = G_; c = c_; ntf = ntf_; }
    __host__ __device__ bool next(int i, Unit& u) const {
        const long L = (long)i * G + c; if (L >= nwg) return false;
        int wgid = (int)L; { const int q = nwg / NXCD, r = nwg % NXCD, xcd = wgid % NXCD, off = wgid / NXCD; wgid = (xcd < r ? xcd * (q + 1) : r * (q + 1) + (xcd - r) * q) + off; }
        const int nig = WGM * nN, gid = wgid / nig, fm = gid * WGM, gsz = (nM - fm) < WGM ? (nM - fm) : WGM;
        u.pm = fm + ((wgid % nig) % gsz); u.pn = (wgid % nig) / gsz; u.kt0 = 0; u.nt = ntf; return true;
    }
    __device__ __forceinline__ void a_ready(const Unit&) const {}
    __device__ __forceinline__ void done(const Unit&) const {}
};

__device__ __forceinline__ unsigned cvt_pk_bf16(float lo, float hi) { unsigned r; asm volatile("v_cvt_pk_bf16_f32 %0, %1, %2" : "=v"(r) : "v"(lo), "v"(hi)); return r; }
typedef float f32x2 __attribute__((ext_vector_type(2)));

struct SplitTailOrder {
    StaticOrder S0; int nsplit, c;
    __host__ __device__ void init(int G_, int c_, int ntf_, int nsplit_) { S0.init(64 * BM, 1024, G_, c_, ntf_); nsplit = nsplit_; c = c_; }
    __host__ __device__ bool next(int i, Unit& u) const {
        if (i == 0) return S0.next(0, u);
        if (i == 1 && c < 4 * nsplit) { u.pm = 64; u.pn = c & 3; u.nt = S0.ntf / nsplit; u.kt0 = (c >> 2) * u.nt; return true; }
        return false;
    }
    __device__ __forceinline__ void a_ready(const Unit&) const {}
    __device__ __forceinline__ void done(const Unit&) const {}
};
constexpr float RMS_EPS = 1e-6f;
constexpr int M_REAL = 16512, SEQ_L = 2064;
__device__ __forceinline__ float row_rs(const float* SS, int row, int fq) {
    const f32x4 a = *(const f32x4*)(SS + (size_t)row * 16 + 4 * fq);
    float s = (a[0] + a[1]) + (a[2] + a[3]);
    s += __shfl_xor(s, 16); s += __shfl_xor(s, 32);
    return __builtin_amdgcn_rsqf(s * (1.0f / 1024.0f) + RMS_EPS);
}
__device__ __forceinline__ void row_rs8(const float* SS, int row0, int fq, float (&rs)[2][4]) {
    f32x4 a[2][4];
#pragma unroll
    for (int ai = 0; ai < 2; ++ai)
#pragma unroll
        for (int m = 0; m < 4; ++m) a[ai][m] = *(const f32x4*)(SS + (size_t)(row0 + ai * HALF + m * 16) * 16 + 4 * fq);
#pragma unroll
    for (int ai = 0; ai < 2; ++ai)
#pragma unroll
        for (int m = 0; m < 4; ++m) { float s = (a[ai][m][0] + a[ai][m][1]) + (a[ai][m][2] + a[ai][m][3]); s += __shfl_xor(s, 16); s += __shfl_xor(s, 32); rs[ai][m] = __builtin_amdgcn_rsqf(s * (1.0f / 1024.0f) + RMS_EPS); }
}
__device__ __forceinline__ float silu_f(float g) { return g * __builtin_amdgcn_rcpf(1.0f + __expf(-g)); }

struct EpiGU {
    static constexpr bool PERM = true, AFTER_DRAIN = false;
    bf16_t* ACT; const float* SS;
    __device__ __forceinline__ void operator()(const f32x4 (&acc)[2][2][4][2], const Unit& u, int wr, int wc, int fr, int fq) const {
        const int row0 = u.pm * BM + wr * 64 + fr, col0 = u.pn * 128 + wc * 32 + 8 * fq;
        float rs8[2][4]; row_rs8(SS, row0, fq, rs8);
#pragma unroll
        for (int ai = 0; ai < 2; ++ai)
#pragma unroll
            for (int m = 0; m < 4; ++m) {
                const int row = row0 + ai * HALF + m * 16; const float rs = rs8[ai][m];
                float o[8];
#pragma unroll
                for (int n = 0; n < 2; ++n)
#pragma unroll
                    for (int j = 0; j < 4; ++j) { const float g = acc[ai][0][m][n][j] * rs, uu = acc[ai][1][m][n][j] * rs; o[4 * n + j] = silu_f(g) * uu; }
                u32x4 w; w.x = cvt_pk_bf16(o[0], o[1]); w.y = cvt_pk_bf16(o[2], o[3]); w.z = cvt_pk_bf16(o[4], o[5]); w.w = cvt_pk_bf16(o[6], o[7]);
                *(u32x4*)(ACT + (size_t)row * 2816 + col0) = w;
                asm volatile("" ::: "memory");
            }
    }
};

struct EpiRes {
    static constexpr bool PERM = true, AFTER_DRAIN = false;
    float* H; bf16_t* HB; float* SS; float* OUT; float wres; float* SLAB; unsigned* CNT; __attribute__((address_space(3))) unsigned char* lds_misc; int FINAL; int nsplit;
    __device__ __forceinline__ void operator()(const f32x4 (&acc)[2][2][4][2], const Unit& u, int wr, int wc, int fr, int fq) const {
        const int row0 = u.pm * BM + wr * 64 + fr, col0 = u.pn * BM + wc * 32 + 8 * fq;
        if (SLAB && u.pm == 64) {
            float* sp = SLAB + ((size_t)(u.kt0 / u.nt) * 256 + wr * 64 + fr) * 1024 + col0;
#pragma unroll
            for (int ai = 0; ai < 2; ++ai)
#pragma unroll
                for (int m = 0; m < 4; ++m)
#pragma unroll
                    for (int bj = 0; bj < 2; ++bj) { float* p = sp + (size_t)(ai * HALF + m * 16) * 1024 + bj * HALF; *(f32x4*)p = acc[ai][bj][m][0]; *(f32x4*)(p + 4) = acc[ai][bj][m][1]; }
            volatile __attribute__((address_space(3))) unsigned* lflag = (volatile __attribute__((address_space(3))) unsigned*)(lds_misc);
            asm volatile("s_waitcnt vmcnt(0)" ::: "memory"); __syncthreads();
            if (wr == 0 && wc == 0 && fr == 0 && fq == 0) { __builtin_amdgcn_fence(__ATOMIC_RELEASE, "agent"); asm volatile("s_waitcnt vmcnt(0)" ::: "memory");
                lflag[0] = __hip_atomic_fetch_add(CNT + u.pn, 1u, __ATOMIC_RELAXED, __HIP_MEMORY_SCOPE_AGENT); }
            __syncthreads();
            const bool last = (lflag[0] == (unsigned)(nsplit - 1));
            if (last) {
                __builtin_amdgcn_fence(__ATOMIC_ACQUIRE, "agent"); asm volatile("s_waitcnt vmcnt(0)" ::: "memory");
                const int lane = fq * 16 + fr, wv = wr * 4 + wc;
                constexpr int RB = 4;
                for (int r0 = wv * 16; r0 < wv * 16 + 16; r0 += RB) {
                    f32x4 a[RB]; unsigned long long hw[RB];
#pragma unroll
                    for (int q = 0; q < RB; ++q) {
                        f32x4 sl[11];
#pragma unroll
                        for (int s = 0; s < 11; ++s) sl[s] = s < nsplit ? *((const f32x4*)(SLAB + ((size_t)s * 256 + r0 + q) * 1024 + u.pn * BM) + lane) : (f32x4){0.f, 0.f, 0.f, 0.f};
                        hw[q] = *(const unsigned long long*)(HB + (size_t)(64 * 256 + r0 + q) * 1024 + u.pn * BM + 4 * lane);
                        a[q] = sl[0];
#pragma unroll
                        for (int s = 1; s < 11; ++s) a[q] += sl[s];
                    }
#pragma unroll
                    for (int q = 0; q < RB; ++q) {
                        const int row = 64 * 256 + r0 + q;
                        bf16_t* hbp = HB + (size_t)row * 1024 + u.pn * BM + 4 * lane;
                        const unsigned lo = (unsigned)hw[q], hi2 = (unsigned)(hw[q] >> 32);
                        const f32x4 v = (f32x4){__builtin_bit_cast(float, lo << 16), __builtin_bit_cast(float, lo & 0xffff0000u), __builtin_bit_cast(float, hi2 << 16), __builtin_bit_cast(float, hi2 & 0xffff0000u)} + a[q] * wres;
                        if (FINAL) { const int bb = row / SEQ_L, tt = row - bb * SEQ_L; if (tt >= 16) *((f32x4*)(OUT + ((size_t)bb * 2048 + (tt - 16)) * 1024 + u.pn * BM) + lane) = v; }
                        else { const unsigned w0 = cvt_pk_bf16(v[0], v[1]), w1 = cvt_pk_bf16(v[2], v[3]); *(unsigned long long*)hbp = (unsigned long long)w0 | ((unsigned long long)w1 << 32);
                            const float r0f = __builtin_bit_cast(float, w0 << 16), r1 = __builtin_bit_cast(float, w0 & 0xffff0000u), r2 = __builtin_bit_cast(float, w1 << 16), r3 = __builtin_bit_cast(float, w1 & 0xffff0000u);
                            float ss = (r0f * r0f + r1 * r1) + (r2 * r2 + r3 * r3);
#pragma unroll
                            for (int o = 1; o < 64; o <<= 1) ss += __shfl_xor(ss, o);
                            if (lane < 4) SS[(size_t)row * 16 + u.pn * 4 + lane] = lane == 0 ? ss : 0.f; }
                    }
                }
            }
            return;
        }
#pragma unroll
        for (int ai = 0; ai < 2; ++ai) {
            u32x4 hpre[4][2];
#pragma unroll
            for (int m = 0; m < 4; ++m)
#pragma unroll
                for (int bj = 0; bj < 2; ++bj) hpre[m][bj] = *(const u32x4*)(HB + (size_t)(row0 + ai * HALF + m * 16) * 1024 + col0 + bj * HALF);
#pragma unroll
            for (int m = 0; m < 4; ++m) {
                const int row = row0 + ai * HALF + m * 16; float ss = 0.f;
                bf16_t* hbp = HB + (size_t)row * 1024 + col0;
                const int bb = row / SEQ_L, tt = row - bb * SEQ_L;
#pragma unroll
                for (int bj = 0; bj < 2; ++bj) {
                    const u32x4 hw = hpre[m][bj];
                    const f32x4 h0 = (f32x4){__builtin_bit_cast(float, hw.x << 16), __builtin_bit_cast(float, hw.x & 0xffff0000u), __builtin_bit_cast(float, hw.y << 16), __builtin_bit_cast(float, hw.y & 0xffff0000u)};
                    const f32x4 h1 = (f32x4){__builtin_bit_cast(float, hw.z << 16), __builtin_bit_cast(float, hw.z & 0xffff0000u), __builtin_bit_cast(float, hw.w << 16), __builtin_bit_cast(float, hw.w & 0xffff0000u)};
                    const f32x4 v0 = h0 + acc[ai][bj][m][0] * wres, v1 = h1 + acc[ai][bj][m][1] * wres;
                    if (FINAL) {
                        if (row < M_REAL && tt >= 16) { float* op = OUT + ((size_t)bb * 2048 + (tt - 16)) * 1024 + col0 + bj * HALF; *(f32x4*)op = v0; *(f32x4*)(op + 4) = v1; }
                    } else {
                        u32x4 w; w.x = cvt_pk_bf16(v0[0], v0[1]); w.y = cvt_pk_bf16(v0[2], v0[3]); w.z = cvt_pk_bf16(v1[0], v1[1]); w.w = cvt_pk_bf16(v1[2], v1[3]);
                        *(u32x4*)(hbp + bj * HALF) = w;
                        const float r0 = __builtin_bit_cast(float, w.x << 16), r1 = __builtin_bit_cast(float, w.x & 0xffff0000u), r2 = __builtin_bit_cast(float, w.y << 16), r3 = __builtin_bit_cast(float, w.y & 0xffff0000u);
                        const float r4 = __builtin_bit_cast(float, w.z << 16), r5 = __builtin_bit_cast(float, w.z & 0xffff0000u), r6 = __builtin_bit_cast(float, w.w << 16), r7 = __builtin_bit_cast(float, w.w & 0xffff0000u);
                        ss += (r0 * r0 + r1 * r1) + (r2 * r2 + r3 * r3) + (r4 * r4 + r5 * r5) + (r6 * r6 + r7 * r7);
                    }
                }
                if (!FINAL) { ss += __shfl_xor(ss, 16); ss += __shfl_xor(ss, 32); if (fq == 0) SS[(size_t)row * 16 + u.pn * 4 + wc] = ss; }
            }
            asm volatile("" ::: "memory");
        }
    }
};

struct EpiQKV {
    static constexpr bool PERM = true, AFTER_DRAIN = false;
    bf16_t* QKV; size_t sec_stride; const float* SS; const float* gq; const float* gk; int VT_LP;
    __device__ __forceinline__ void operator()(const f32x4 (&acc)[2][2][4][2], const Unit& u, int wr, int wc, int fr, int fq) const {
        const int row0 = u.pm * BM + wr * 64 + fr; const int sec = u.pn >> 2, pt = u.pn & 3;
        const float* gn = sec == 0 ? gq : gk; bf16_t* dst = QKV + (size_t)sec * sec_stride;
        f32x4 gv[2][2];
#pragma unroll
        for (int bj = 0; bj < 2; ++bj)
#pragma unroll
            for (int n = 0; n < 2; ++n) gv[bj][n] = *(const f32x4*)(gn + 32 * bj + 8 * fq + 4 * n);
        float rs8[2][4]; row_rs8(SS, row0, fq, rs8);
#pragma unroll
        for (int ai = 0; ai < 2; ++ai)
#pragma unroll
            for (int m = 0; m < 4; ++m) {
                const int row = row0 + ai * HALF + m * 16; const float rs = rs8[ai][m];
                const int bb = row / SEQ_L, tt = row - bb * SEQ_L;
                f32x4 x[2][2];
#pragma unroll
                for (int bj = 0; bj < 2; ++bj)
#pragma unroll
                    for (int n = 0; n < 2; ++n) x[bj][n] = acc[ai][bj][m][n] * rs;
                if (sec < 2) {
                    float ss = 0.f;
#pragma unroll
                    for (int bj = 0; bj < 2; ++bj)
#pragma unroll
                        for (int n = 0; n < 2; ++n) ss += (x[bj][n][0] * x[bj][n][0] + x[bj][n][1] * x[bj][n][1]) + (x[bj][n][2] * x[bj][n][2] + x[bj][n][3] * x[bj][n][3]);
                    ss += __shfl_xor(ss, 16); ss += __shfl_xor(ss, 32);
                    const float r = __builtin_amdgcn_rsqf(ss * (1.0f / 64.0f) + RMS_EPS);
#pragma unroll
                    for (int bj = 0; bj < 2; ++bj)
#pragma unroll
                        for (int n = 0; n < 2; ++n) x[bj][n] = x[bj][n] * r * gv[bj][n];
                }
                if (row < M_REAL && sec == 2 && VT_LP) {
                    const int kt = tt >> 5, s = (tt >> 4) & 1, k16 = tt & 15, hl = (k16 >> 2) & 1, jj = (k16 & 3) + 4 * (k16 >> 3);
#pragma unroll
                    for (int bj = 0; bj < 2; ++bj) {
                        const int c = 256 * pt + 128 * bj + 32 * wc + 8 * fq, head = c >> 6, dim = c & 63;
                        bf16_t* vp = dst + (((size_t)(bb * 16 + head) * 65 + kt) * 2 + (dim >> 5)) * 1024 + ((dim & 31) + 32 * hl) * 16 + 8 * s + jj;
#pragma unroll
                        for (int n = 0; n < 2; ++n)
#pragma unroll
                            for (int i = 0; i < 4; ++i) vp[(4 * n + i) * 16] = (bf16_t)(cvt_pk_bf16(x[bj][n][i], x[bj][n][i]) & 0xffffu);
                    }
                } else if (row < M_REAL) {
#pragma unroll
                    for (int bj = 0; bj < 2; ++bj) {
                        int head, dim;
                        if (sec < 2) { head = 4 * pt + wc; dim = 32 * bj + 8 * fq; }
                        else { const int c = 256 * pt + 128 * bj + 32 * wc + 8 * fq; head = c >> 6; dim = c & 63; }
                        u32x4 w; w.x = cvt_pk_bf16(x[bj][0][0], x[bj][0][1]); w.y = cvt_pk_bf16(x[bj][0][2], x[bj][0][3]); w.z = cvt_pk_bf16(x[bj][1][0], x[bj][1][1]); w.w = cvt_pk_bf16(x[bj][1][2], x[bj][1][3]);
                        *(u32x4*)(dst + ((size_t)(bb * 16 + head) * SEQ_L + tt) * 64 + dim) = w;
                    }
                }
                asm volatile("" ::: "memory");
            }
    }
};

struct EpiGLAIn {
    static constexpr bool PERM = true, AFTER_DRAIN = false;
    bf16_t* P; float* GL; const float* SS;
    __device__ __forceinline__ void operator()(const f32x4 (&acc)[2][2][4][2], const Unit& u, int wr, int wc, int fr, int fq) const {
        const int row0 = u.pm * BM + wr * 64 + fr, col0 = u.pn * BM + wc * 32 + 8 * fq;
        float rs8[2][4]; row_rs8(SS, row0, fq, rs8);
#pragma unroll
        for (int ai = 0; ai < 2; ++ai)
#pragma unroll
            for (int m = 0; m < 4; ++m) {
                const int row = row0 + ai * HALF + m * 16; const float rs = rs8[ai][m];
                if (u.pn < 12) {
#pragma unroll
                    for (int bj = 0; bj < 2; ++bj) {
                        const f32x4 v0 = acc[ai][bj][m][0] * rs, v1 = acc[ai][bj][m][1] * rs;
                        u32x4 w; w.x = cvt_pk_bf16(v0[0], v0[1]); w.y = cvt_pk_bf16(v0[2], v0[3]); w.z = cvt_pk_bf16(v1[0], v1[1]); w.w = cvt_pk_bf16(v1[2], v1[3]);
                        *(u32x4*)(P + (size_t)row * 3072 + col0 + bj * HALF) = w;
                    }
                } else if (wc == 0 && fq < 2) {
                    const f32x4 v0 = acc[ai][0][m][0] * rs, v1 = acc[ai][0][m][1] * rs;
                    *(f32x4*)(GL + (size_t)row * 16 + 8 * fq) = v0; *(f32x4*)(GL + (size_t)row * 16 + 8 * fq + 4) = v1;
                }
                asm volatile("" ::: "memory");
            }
    }
};

struct EpiAny {
    static constexpr bool PERM = true, AFTER_DRAIN = false;
    int kind; EpiGU gu; EpiQKV qkv; EpiGLAIn gin;
    __device__ __forceinline__ void operator()(const f32x4 (&acc)[2][2][4][2], const Unit& u, int wr, int wc, int fr, int fq) const {
        if (kind == 0) gu(acc, u, wr, wc, fr, fq); else if (kind == 1) qkv(acc, u, wr, wc, fr, fq); else gin(acc, u, wr, wc, fr, fq);
    }
};
template <class Epi, class Sched, bool ALIGN_EPI = false, bool SP2 = false>
__device__ __forceinline__ void gemm_phase(PG8_LAS unsigned char* lds, const Gemm g, const Sched& S, const Epi& E) {
    int tid_ = threadIdx.x; asm volatile("" : "+v"(tid_)); const int tid = tid_, wid = __builtin_amdgcn_readfirstlane(tid >> 6), lane = tid & 63, wr = wid >> 2, wc = wid & 3, fr = lane & 15, fq = lane >> 4;
    const int K = g.K;
    unsigned voffA[2], voffB[2];
#pragma unroll
    for (int i = 0; i < 2; ++i) { int R, C; stage_rc(tid * 16 + i * 8192, R, C); const int Rb = Epi::PERM ? ((R & ~31) + perm32(R & 31)) : R;
        voffA[i] = (unsigned)(R * K + C) * 2u; voffB[i] = (unsigned)(Rb * K + C) * 2u; }
    const size_t kstep = (size_t)(BK * 2);
    const size_t hstep = (size_t)HALF * K * 2;
    const size_t tstep = 2 * hstep;
    const unsigned ldsw = (unsigned)wid * 1024u;
    const int aoff = lds_byte(wr * 64 + fr, fq * 8), boff = lds_byte(wc * 32 + fr, fq * 8);
#define PG8_SA(b, h) (((b) * 2 + (h)) * HTB)
#define PG8_SB(b, h) ((4 + (b) * 2 + (h)) * HTB)
#define PG8_STAGE(bufoff, gbase, voff) do { _Pragma("unroll") for (int _i = 0; _i < 2; ++_i) \
        __builtin_amdgcn_global_load_lds((const unsigned*)((const char*)(gbase) + (voff)[_i]), (PG8_LAS unsigned*)(lds + (bufoff) + ldsw + _i * 8192), 16, 0, 0); } while (0)
#define PG8_LDA(dst, b, h) do { _Pragma("unroll") for (int m = 0; m < 4; ++m) _Pragma("unroll") for (int k = 0; k < 2; ++k) dst[m][k] = *(const PG8_LAS bf16x8*)(lds + PG8_SA(b, h) + aoff + m * 2048 + k * 1024); } while (0)
#define PG8_LDB(dst, b, h) do { _Pragma("unroll") for (int n = 0; n < 2; ++n) _Pragma("unroll") for (int k = 0; k < 2; ++k) dst[n][k] = *(const PG8_LAS bf16x8*)(lds + PG8_SB(b, h) + boff + n * 2048 + k * 1024); } while (0)
#define PG8_MMA(ai, bj, At, Bt) do { __builtin_amdgcn_s_setprio(1); _Pragma("unroll") for (int m = 0; m < 4; ++m) _Pragma("unroll") for (int n = 0; n < 2; ++n) _Pragma("unroll") for (int k = 0; k < 2; ++k) \
        acc[ai][bj][m][n] = __builtin_amdgcn_mfma_f32_16x16x32_bf16(Bt[n][k], At[m][k], acc[ai][bj][m][n], 0, 0, 0); __builtin_amdgcn_s_setprio(0); } while (0)
#define PG8_WAIT_V(n) asm volatile("s_waitcnt vmcnt(" #n ")" ::: "memory")
#define PG8_WAIT_L(n) asm volatile("s_waitcnt lgkmcnt(" #n ")" ::: "memory")
#define PG8_BAR __builtin_amdgcn_s_barrier()
#define PG8_SCHED __builtin_amdgcn_sched_barrier(0)
    Unit cur, nxt; int ui = 0;
    if (!S.next(0, cur)) return;
    f32x4 acc[2][2][4][2];
#pragma unroll
    for (int a = 0; a < 2; ++a)
#pragma unroll
        for (int b = 0; b < 2; ++b)
#pragma unroll
            for (int m = 0; m < 4; ++m)
#pragma unroll
                for (int n = 0; n < 2; ++n) acc[a][b][m][n] = (f32x4){0.f, 0.f, 0.f, 0.f};
    bf16x8 At[4][2], B0[2][2], B1[2][2];
    const char* cA = (const char*)g.A + (size_t)cur.pm * tstep + (size_t)cur.kt0 * kstep; const char* cB = (const char*)g.Bt + (size_t)cur.pn * tstep + (size_t)cur.kt0 * kstep;
    S.a_ready(cur);
    if constexpr (SP2) {
        PG8_STAGE(PG8_SB(0, 0), cB, voffB); PG8_STAGE(PG8_SB(0, 1), cB + hstep, voffB); PG8_STAGE(PG8_SA(0, 0), cA, voffA); PG8_STAGE(PG8_SA(0, 1), cA + hstep, voffA);
        if (wr == 1) PG8_BAR;
        PG8_WAIT_V(2); PG8_BAR;
        PG8_STAGE(PG8_SB(1, 0), cB + kstep, voffB); PG8_STAGE(PG8_SA(1, 0), cA + kstep, voffA); PG8_STAGE(PG8_SB(1, 1), cB + hstep + kstep, voffB);
        PG8_WAIT_V(6); PG8_BAR;
    } else {
        PG8_STAGE(PG8_SB(0, 0), cB, voffB); PG8_STAGE(PG8_SA(0, 0), cA, voffA); PG8_STAGE(PG8_SB(0, 1), cB + hstep, voffB); PG8_STAGE(PG8_SA(0, 1), cA + hstep, voffA);
        if (wr == 1) PG8_BAR;
        PG8_WAIT_V(4); PG8_BAR;
        PG8_STAGE(PG8_SB(1, 0), cB + kstep, voffB); PG8_STAGE(PG8_SA(1, 0), cA + kstep, voffA); PG8_STAGE(PG8_SB(1, 1), cB + hstep + kstep, voffB);
        PG8_WAIT_V(6); PG8_BAR;
    }
    for (;;) {
        const bool has_next = S.next(ui + 1, nxt);
        const char* nA = has_next ? (const char*)g.A + (size_t)nxt.pm * tstep + (size_t)nxt.kt0 * kstep : cA; const char* nB = has_next ? (const char*)g.Bt + (size_t)nxt.pn * tstep + (size_t)nxt.kt0 * kstep : cB;
        const int nt = cur.nt;
        for (int t = 0; t < nt; t += 2) {
            const bool last = (t == nt - 2);
            const char* a1 = cA + (size_t)(t + 1) * kstep;
            const char* a2 = last ? nA : cA + (size_t)(t + 2) * kstep; const char* b2 = last ? nB : cB + (size_t)(t + 2) * kstep;
            const char* a3 = a2 + kstep; const char* b3 = b2 + kstep;
            if (last && has_next) S.a_ready(nxt);
            if constexpr (SP2) {
            PG8_LDB(B0, 0, 0); PG8_LDB(B1, 0, 1); PG8_SCHED; PG8_LDA(At, 0, 0); PG8_STAGE(PG8_SA(1, 1), a1 + hstep, voffA);
            PG8_WAIT_V(8); PG8_WAIT_L(0); PG8_BAR; PG8_MMA(0, 0, At, B0); PG8_MMA(0, 1, At, B1); PG8_BAR; PG8_SCHED;
            PG8_LDA(At, 0, 1); PG8_STAGE(PG8_SB(0, 0), b2, voffB); PG8_STAGE(PG8_SB(0, 1), b2 + hstep, voffB); PG8_STAGE(PG8_SA(0, 0), a2, voffA);
            PG8_WAIT_V(8); PG8_WAIT_L(0); PG8_BAR; PG8_MMA(1, 0, At, B0); PG8_MMA(1, 1, At, B1); PG8_BAR; PG8_SCHED;
            PG8_LDB(B0, 1, 0); PG8_LDB(B1, 1, 1); PG8_SCHED; PG8_LDA(At, 1, 0); PG8_STAGE(PG8_SA(0, 1), a2 + hstep, voffA);
            PG8_WAIT_V(8); PG8_WAIT_L(0); PG8_BAR; PG8_MMA(0, 0, At, B0); PG8_MMA(0, 1, At, B1); PG8_BAR; PG8_SCHED;
            PG8_LDA(At, 1, 1); PG8_STAGE(PG8_SB(1, 0), b3, voffB); PG8_STAGE(PG8_SB(1, 1), b3 + hstep, voffB); PG8_STAGE(PG8_SA(1, 0), a3, voffA);
            PG8_WAIT_V(8); PG8_WAIT_L(0); PG8_BAR; PG8_MMA(1, 0, At, B0); PG8_MMA(1, 1, At, B1); PG8_BAR; PG8_SCHED;
            } else {
            PG8_LDB(B0, 0, 0); PG8_SCHED; PG8_LDA(At, 0, 0); PG8_STAGE(PG8_SA(1, 1), a1 + hstep, voffA);
            PG8_WAIT_L(8); PG8_BAR; PG8_WAIT_L(0); PG8_MMA(0, 0, At, B0); PG8_BAR; PG8_SCHED;
            PG8_LDB(B1, 0, 1); PG8_STAGE(PG8_SB(0, 0), b2, voffB);
            PG8_BAR; PG8_WAIT_L(0); PG8_MMA(0, 1, At, B1); PG8_BAR;
            PG8_LDA(At, 0, 1); PG8_STAGE(PG8_SA(0, 0), a2, voffA);
            PG8_BAR; PG8_WAIT_L(0); PG8_MMA(1, 0, At, B0); PG8_BAR; PG8_SCHED;
            PG8_STAGE(PG8_SB(0, 1), b2 + hstep, voffB);
            PG8_WAIT_V(6); PG8_BAR; PG8_MMA(1, 1, At, B1); PG8_BAR;
            PG8_LDB(B0, 1, 0); PG8_SCHED; PG8_LDA(At, 1, 0); PG8_STAGE(PG8_SA(0, 1), a2 + hstep, voffA);
            PG8_WAIT_L(8); PG8_BAR; PG8_WAIT_L(0); PG8_MMA(0, 0, At, B0); PG8_BAR; PG8_SCHED;
            PG8_LDB(B1, 1, 1); PG8_STAGE(PG8_SB(1, 0), b3, voffB);
            PG8_BAR; PG8_WAIT_L(0); PG8_MMA(0, 1, At, B1); PG8_BAR;
            PG8_LDA(At, 1, 1); PG8_STAGE(PG8_SA(1, 0), a3, voffA);
            PG8_BAR; PG8_WAIT_L(0); PG8_MMA(1, 0, At, B0); PG8_BAR; PG8_SCHED;
            PG8_STAGE(PG8_SB(1, 1), b3 + hstep, voffB);
            PG8_WAIT_V(6); PG8_BAR; PG8_MMA(1, 1, At, B1); PG8_BAR;
            }
        }
        if constexpr (ALIGN_EPI) { if (wr == 0) PG8_BAR; }
        if constexpr (!Epi::AFTER_DRAIN) { E(acc, cur, wr, wc, fr, fq); S.done(cur); }
        if (!has_next) break;
#pragma unroll
        for (int a = 0; a < 2; ++a)
#pragma unroll
            for (int b = 0; b < 2; ++b)
#pragma unroll
                for (int m = 0; m < 4; ++m)
#pragma unroll
                    for (int n = 0; n < 2; ++n) acc[a][b][m][n] = (f32x4){0.f, 0.f, 0.f, 0.f};
        cur = nxt; cA = nA; cB = nB; ++ui;
        if constexpr (ALIGN_EPI) { if (wr == 1) PG8_BAR; }
    }
    PG8_WAIT_V(0);
    if constexpr (!ALIGN_EPI) { if (wr == 0) PG8_BAR; }
    PG8_BAR;
    if constexpr (Epi::AFTER_DRAIN) { E.fused(acc, cur, wr, wc, fr, fq, lds, wid, lane); S.done(cur); }
#undef PG8_SA
#undef PG8_SB
#undef PG8_STAGE
#undef PG8_LDA
#undef PG8_LDB
#undef PG8_MMA
#undef PG8_WAIT_V
#undef PG8_WAIT_L
#undef PG8_BAR
#undef PG8_SCHED
}
}
namespace cg = cooperative_groups;
#define LAS __attribute__((address_space(3)))
typedef unsigned short bf16;
typedef unsigned v4u __attribute__((ext_vector_type(4)));
typedef unsigned v2u __attribute__((ext_vector_type(2)));
typedef float f32x4 __attribute__((ext_vector_type(4)));
constexpr int NWAVES = 8, NTHR = 512;
constexpr int NB = 8, SEQ = 2048, NMETA = 16, L = 2064, D = 1024, FF = 2816, DEPTH = 4;
constexpr int M = NB * L;
constexpr int MP = 16640;
constexpr int GLA_IN = 3088, GLA_INP = 3328;
constexpr size_t MiB = 1u << 20;
constexpr size_t WS_SS = 1 * MiB, WS_H = 3 * MiB, WS_HB = 68 * MiB;
constexpr size_t WS_WGUA = 101 * MiB, WS_WDA = 112 * MiB, WS_WGUB = 118 * MiB, WS_WDB = 129 * MiB, WS_WMIX = 135 * MiB, WS_WO = 142 * MiB;
constexpr size_t WS_ACT = 144 * MiB;
constexpr size_t WS_Q = 144 * MiB, WS_K = 177 * MiB, WS_V = 210 * MiB, WS_O = 243 * MiB;
constexpr size_t WS_GP = 144 * MiB, WS_GGL = 242 * MiB, WS_GA = 244 * MiB, WS_GOG = 277 * MiB, WS_GGA = 343 * MiB, WS_SLAB = 376 * MiB, WS_END = 388 * MiB;
static_assert(WS_V - WS_K == WS_K - WS_Q, "Q|K|V equally spaced");
constexpr int LDS_BYTES = 147456;

__device__ __forceinline__ unsigned f2bf(float f) { unsigned u = __builtin_bit_cast(unsigned, f); return (u + 0x7fffu + ((u >> 16) & 1u)) >> 16; }
typedef float f32x2_t __attribute__((ext_vector_type(2))); typedef __bf16 bf16x2_t __attribute__((ext_vector_type(2)));
__device__ __forceinline__ unsigned pk2(float lo, float hi) { const f32x2_t v = {lo, hi}; return __builtin_bit_cast(unsigned, __builtin_convertvector(v, bf16x2_t)); }
__device__ __forceinline__ float bflo(unsigned u) { return __builtin_bit_cast(float, u << 16); }
__device__ __forceinline__ float bfhi(unsigned u) { return __builtin_bit_cast(float, u & 0xffff0000u); }
__device__ __forceinline__ float wave_sum(float v) {
#pragma unroll
    for (int o = 1; o < 64; o <<= 1) v += __shfl_xor(v, o);
    return v;
}

constexpr size_t WS_CTL = 0, CTL_ZERO_BYTES = 65536; constexpr int CW_BAR = 4096, CW_CNT = 8192;
typedef __attribute__((address_space(1))) unsigned gu32;
#define XB_TMO      128
#define XB_XCNT(j)  (256  + 64 * (j))
#define XB_XSUB(j)  (1280 + 64 * (j))
#define XB_XGEN(j)  (2304 + 64 * (j))
#define XB_TOP      3328
#define XB_TOPGEN   3392
#define XCD_BAR_WORDS 3456
#define XB_SPIN_CAP (1u << 18)

__device__ __forceinline__ unsigned xb_ld(unsigned* p)              { return __hip_atomic_load(p, __ATOMIC_RELAXED, __HIP_MEMORY_SCOPE_AGENT); }
__device__ __forceinline__ unsigned xb_add(unsigned* p, unsigned v) { return __hip_atomic_fetch_add(p, v, __ATOMIC_RELAXED, __HIP_MEMORY_SCOPE_AGENT); }
__device__ __forceinline__ unsigned xb_xcc_id() { return (unsigned)__builtin_amdgcn_s_getreg((3 << 11) | 20) & 0xFu; }
#define XB_SPIN(cond, bar) do { unsigned _sp = 0; while (cond) { __builtin_amdgcn_s_sleep(1); \
    if ((++_sp & 255u) == 0u) { if (xb_ld(&(bar)[XB_TMO])) break; if (_sp > XB_SPIN_CAP) { atomicAdd(&(bar)[XB_TMO], 1u); break; } } } } while (0)

struct XcdBarrier {
    unsigned* bar; unsigned x;
    volatile LAS unsigned* st;
};

__device__ __forceinline__ XcdBarrier xcd_barrier_post(unsigned* bar, volatile LAS unsigned* st) {
    XcdBarrier b; b.bar = bar; b.x = xb_xcc_id(); b.st = st;
    if (threadIdx.x == 0) (void)xb_add(&bar[XB_XCNT(b.x)], 1u);
    return b;
}
__device__ __forceinline__ void xcd_barrier_complete(unsigned* bar, unsigned x, unsigned& nloc, unsigned& nx) {
    const unsigned G = gridDim.x * gridDim.y * gridDim.z;
    unsigned sum, cnt, mine, sp = 0u;
    for (;;) {
        sum = 0u; cnt = 0u; mine = 0u;
#pragma unroll
        for (unsigned j = 0; j < 16; ++j) { const unsigned c = xb_ld(&bar[XB_XCNT(j)]); sum += c; cnt += (c > 0u) ? 1u : 0u; mine = (j == x) ? c : mine; }
        if (sum == G) break;
        __builtin_amdgcn_s_sleep(1);
        if ((++sp & 255u) == 0u) { if (xb_ld(&bar[XB_TMO])) break; if (sp > XB_SPIN_CAP) { atomicAdd(&bar[XB_TMO], 1u); break; } }
    }
    nloc = mine > 0u ? mine : 1u; nx = cnt > 0u ? cnt : 1u;
}

__device__ __forceinline__ void xcd_barrier(const XcdBarrier& b) {
    asm volatile("s_waitcnt vmcnt(0)" ::: "memory");
    __syncthreads();
    if (threadIdx.x == 0) {
        unsigned* bar = b.bar;
        __builtin_amdgcn_s_waitcnt(0);
        unsigned nloc = b.st[0], nx = b.st[1];
        if (nloc == 0u) { xcd_barrier_complete(bar, b.x, nloc, nx); b.st[0] = nloc; b.st[1] = nx; }
        const unsigned old = xb_add(&bar[XB_XSUB(b.x)], 1u);
        const unsigned gen = old / nloc;
        if (old + 1u == (gen + 1u) * nloc) {
            __builtin_amdgcn_fence(__ATOMIC_RELEASE, "agent");
            asm volatile("s_waitcnt vmcnt(0)" ::: "memory");
            const unsigned og = xb_add(&bar[XB_TOP], 1u);
            const unsigned tg = og / nx;
            if (og + 1u == (tg + 1u) * nx) xb_add(&bar[XB_TOPGEN], 1u);
            else XB_SPIN(xb_ld(&bar[XB_TOPGEN]) == tg, bar);
            __builtin_amdgcn_fence(__ATOMIC_ACQUIRE, "agent");
            xb_add(&bar[XB_XGEN(b.x)], 1u);
            asm volatile("s_waitcnt vmcnt(0)" ::: "memory");
        } else {
            XB_SPIN(xb_ld(&bar[XB_XGEN(b.x)]) == gen, bar);
            __builtin_amdgcn_fence(__ATOMIC_ACQUIRE, "agent");
            asm volatile("s_waitcnt vmcnt(0)" ::: "memory");
        }
    }
    __syncthreads();
}

struct Args { const float* in[18]; float* out; unsigned char* ws; };
typedef const __attribute__((address_space(4))) unsigned char* kptr_t;
__device__ __forceinline__ unsigned long long karg(int i) { kptr_t ka = (kptr_t)__builtin_amdgcn_kernarg_segment_ptr(); asm volatile("" : "+s"(ka)); return *(const __attribute__((address_space(4))) unsigned long long*)(ka + 8 * i); }
#define KIN(i) ((const float*)(const __attribute__((address_space(1))) float*)karg(i))
#define KOUT ((float*)(__attribute__((address_space(1))) float*)karg(18))
#define KWS ((unsigned char*)(__attribute__((address_space(1))) unsigned char*)karg(19))

struct ConvP { const float* src; const float* gain; bf16* dst; int ldw, K; };
__device__ __forceinline__ int gu_dest(int c) { return c < FF ? 256 * (c >> 7) + (c & 127) : 256 * ((c - FF) >> 7) + 128 + ((c - FF) & 127); }
__device__ __forceinline__ int qkv_dest(int c) {
    const int sec = c >> 10, cc = c & 1023; if (sec == 2) return c;
    const int head = cc >> 6, dd = cc & 63; return 1024 * sec + 256 * (head >> 2) + 128 * (dd >> 5) + 32 * (head & 3) + (dd & 31);
}
constexpr int CONV_I_GU = 16 * 176, CONV_I_D = 44 * 32, CONV_I_IN = 16 * 96, CONV_I_O = 16 * 32, CONV_NIT = 2 * (CONV_I_GU + CONV_I_D) + CONV_I_IN + CONV_I_O;
__device__ __forceinline__ ConvP conv_params(int it, int layer, unsigned char* ws) {
    const int j = layer >> 1; const bool sb = (layer & 1) == 0;
    const float* W; const float* gain = nullptr; bf16* WT; int ldw, K, kb, nb, dest0;
    int r = it;
    if (r < CONV_I_GU) { kb = r / 176; nb = r % 176; W = KIN(3) + (size_t)layer * D * 2 * FF; ldw = 2 * FF; K = D; WT = (bf16*)(ws + WS_WGUA); dest0 = gu_dest(32 * nb); gain = KIN(2) + layer * D; }
    else if ((r -= CONV_I_GU) < CONV_I_D) { kb = r / 32; nb = r % 32; W = KIN(4) + (size_t)layer * FF * D; ldw = D; K = FF; WT = (bf16*)(ws + WS_WDA); dest0 = 32 * nb; }
    else if ((r -= CONV_I_D) < CONV_I_GU) { kb = r / 176; nb = r % 176; W = KIN(16) + (size_t)layer * D * 2 * FF; ldw = 2 * FF; K = D; WT = (bf16*)(ws + WS_WGUB); dest0 = gu_dest(32 * nb); gain = KIN(15) + layer * D; }
    else if ((r -= CONV_I_GU) < CONV_I_D) { kb = r / 32; nb = r % 32; W = KIN(17) + (size_t)layer * FF * D; ldw = D; K = FF; WT = (bf16*)(ws + WS_WDB); dest0 = 32 * nb; }
    else if ((r -= CONV_I_D) < CONV_I_IN) { kb = r / 96; nb = r % 96; K = D; WT = (bf16*)(ws + WS_WMIX); gain = KIN(5) + layer * D;
        if (sb) { W = KIN(6) + (size_t)j * D * 3 * D; ldw = 3 * D; dest0 = qkv_dest(32 * nb); } else { W = KIN(10) + (size_t)j * D * GLA_IN; ldw = GLA_IN; dest0 = 32 * nb; } }
    else { r -= CONV_I_IN; kb = r / 32; nb = r % 32; W = (sb ? KIN(9) : KIN(14)) + (size_t)j * D * D; ldw = D; K = D; WT = (bf16*)(ws + WS_WO); dest0 = 32 * nb; }
    ConvP p; p.src = W + (size_t)(64 * kb) * ldw + 32 * nb; p.gain = gain ? gain + 64 * kb : nullptr; p.dst = WT + (size_t)dest0 * K + 64 * kb; p.ldw = ldw; p.K = K; return p;
}
__device__ __forceinline__ void conv_load(const ConvP& p, int lane, f32x4 (&v)[8], float (&g)[8]) {
    const int c4 = lane & 7, r8 = lane >> 3;
#pragma unroll
    for (int i = 0; i < 8; ++i) { v[i] = *(const f32x4*)(p.src + (size_t)(8 * i + r8) * p.ldw + 4 * c4); g[i] = p.gain ? p.gain[8 * i + r8] : 1.0f; }
}
__device__ __forceinline__ void conv_store(const ConvP& p, int lane, const f32x4 (&v)[8], const float (&g)[8], LAS float* scr) {
    const int c4 = lane & 7, r8 = lane >> 3;
#pragma unroll
    for (int i = 0; i < 8; ++i) { LAS float* s = scr + (8 * i + r8) * 33 + 4 * c4; s[0] = v[i][0] * g[i]; s[1] = v[i][1] * g[i]; s[2] = v[i][2] * g[i]; s[3] = v[i][3] * g[i]; }
    asm volatile("s_waitcnt lgkmcnt(0)" ::: "memory");
    const int c = lane & 7;
#pragma unroll
    for (int jj = 0; jj < 4; ++jj) { const int n = (lane >> 3) + 8 * jj; const LAS float* s = scr + (8 * c) * 33 + n;
        v4u o; o.x = pk2(s[0 * 33], s[1 * 33]); o.y = pk2(s[2 * 33], s[3 * 33]); o.z = pk2(s[4 * 33], s[5 * 33]); o.w = pk2(s[6 * 33], s[7 * 33]);
        *(v4u*)(p.dst + (size_t)n * p.K + 8 * c) = o; }
    asm volatile("s_waitcnt lgkmcnt(0)" ::: "memory");
}
__device__ __forceinline__ int conv_item_index(int ci, int part) {
    constexpr int AB = CONV_I_GU + CONV_I_D;
    return part == 0 ? (ci < AB ? ci : ci + AB) : part == 1 ? ci + AB : (part == 2 || part == 5) ? ci : ci + 2 * AB;
}
__device__ __forceinline__ void conv_phase(const Args& a, unsigned char* ws, int layer, int part, LAS unsigned char* lds, int gw, int NGW, int wave, int lane, int gtid, int GT) {
    LAS float* scr = (LAS float*)(lds + wave * 16384);
    const int j = layer >> 1; const bool sb = (layer & 1) == 0;
    constexpr int AB = CONV_I_GU + CONV_I_D;
    const int ncomp = part == 0 ? CONV_NIT - AB : part == 3 ? CONV_I_IN + CONV_I_O : AB;
    if (gw < ncomp) {
        ConvP cur = conv_params(conv_item_index(gw, part), layer, ws); f32x4 v[8]; float g[8];
        conv_load(cur, lane, v, g);
#pragma unroll 1
        for (int ci = gw; ci < ncomp; ci += NGW) {
            const bool has = ci + NGW < ncomp;
            ConvP nxt = conv_params(conv_item_index(has ? ci + NGW : ci, part), layer, ws); f32x4 vn[8]; float gn[8];
            conv_load(nxt, lane, vn, gn);
            conv_store(cur, lane, v, g, scr);
            cur = nxt;
#pragma unroll
            for (int i = 0; i < 8; ++i) { v[i] = vn[i]; g[i] = gn[i]; }
        }
    }
    if (!sb && (part == 0 || part == 3)) {
        const float* W = KIN(10) + (size_t)j * D * GLA_IN; const float* gain = KIN(5) + layer * D; bf16* WT = (bf16*)(ws + WS_WMIX) + (size_t)3072 * D;
        for (int idx = gtid; idx < 256 * D; idx += GT) { const int r = idx >> 10, k = idx & 1023; WT[idx] = (bf16)(r < 16 ? f2bf(W[(size_t)k * GLA_IN + 3072 + r] * gain[k]) : 0u); }
    }
}

__device__ __forceinline__ void prologue_rows(const Args& a, unsigned char* ws, int gw, int NGW, int lane) {
    float* H = (float*)(ws + WS_H); bf16* HB = (bf16*)(ws + WS_HB); float* SS = (float*)(ws + WS_SS);
    for (int m = gw; m < MP; m += NGW) {
        f32x4 v[4]; float s = 0.f;
        if (m < M) { const int b = m / L, t = m - b * L; const float* src = t < NMETA ? KIN(1) + (size_t)t * D : KIN(0) + ((size_t)b * SEQ + (t - NMETA)) * D;
#pragma unroll
            for (int j = 0; j < 4; ++j) { v[j] = *((const f32x4*)src + lane + 64 * j); s += (v[j][0] * v[j][0] + v[j][1] * v[j][1]) + (v[j][2] * v[j][2] + v[j][3] * v[j][3]); }
        } else {
#pragma unroll
            for (int j = 0; j < 4; ++j) v[j] = (f32x4){0.f, 0.f, 0.f, 0.f};
        }
        s = 0.f;
#pragma unroll
        for (int j = 0; j < 4; ++j) { v2u w; w.x = pk2(v[j][0], v[j][1]); w.y = pk2(v[j][2], v[j][3]); *((v2u*)(HB + (size_t)m * D) + lane + 64 * j) = w;
            const float r0 = bflo(w.x), r1 = bfhi(w.x), r2 = bflo(w.y), r3 = bfhi(w.y); s += (r0 * r0 + r1 * r1) + (r2 * r2 + r3 * r3); }
        s = wave_sum(s);
        if (lane < 16) SS[(size_t)m * 16 + lane] = lane == 0 ? s : 0.f;
    }
}

__device__ __forceinline__ void sb_attn_phase(const bf16* Q, const bf16* K, const bf16* V, bf16* O, int gw, int NGW, int lane) {
    constexpr int NQB = (L + 63) / 64;
    for (int wu = gw; wu < NB * 16 * NQB; wu += NGW) {
        const int bh = wu / NQB, qb = wu - bh * NQB; const int t = qb * 64 + lane; const bool valid = t < L;
        const size_t base = (size_t)bh * L * 64;
        float q[64], o[64];
        if (valid) {
            const v4u* qp = (const v4u*)(Q + base + (size_t)t * 64);
#pragma unroll
            for (int c = 0; c < 8; ++c) { const v4u r = qp[c];
                q[8 * c + 0] = bflo(r.x) * 0.125f; q[8 * c + 1] = bfhi(r.x) * 0.125f; q[8 * c + 2] = bflo(r.y) * 0.125f; q[8 * c + 3] = bfhi(r.y) * 0.125f;
                q[8 * c + 4] = bflo(r.z) * 0.125f; q[8 * c + 5] = bfhi(r.z) * 0.125f; q[8 * c + 6] = bflo(r.w) * 0.125f; q[8 * c + 7] = bfhi(r.w) * 0.125f; }
        } else {
#pragma unroll
            for (int c = 0; c < 64; ++c) q[c] = 0.f;
        }
#pragma unroll
        for (int c = 0; c < 64; ++c) o[c] = 0.f;
        float carry = 0.f;
        for (int i = 1; i < L; ++i) {
            const int s = t - i; const bool act = valid && s >= 0 && carry > -104.0f;
            if (__ballot(act) == 0ull) break;
            if (act) {
                const v4u* kp = (const v4u*)(K + base + (size_t)s * 64);
                float z0 = 0.f, z1 = 0.f;
#pragma unroll
                for (int c = 0; c < 8; ++c) { const v4u r = kp[c];
                    z0 += q[8 * c + 0] * bflo(r.x); z1 += q[8 * c + 1] * bfhi(r.x); z0 += q[8 * c + 2] * bflo(r.y); z1 += q[8 * c + 3] * bfhi(r.y);
                    z0 += q[8 * c + 4] * bflo(r.z); z1 += q[8 * c + 5] * bfhi(r.z); z0 += q[8 * c + 6] * bflo(r.w); z1 += q[8 * c + 7] * bfhi(r.w); }
                const float z = z0 + z1;
                const float sp = fmaxf(z, 0.f) + __logf(1.0f + __expf(-fabsf(z)));
                const float w = __expf(z - sp + carry);
                carry -= sp;
                const v4u* vp = (const v4u*)(V + base + (size_t)s * 64);
#pragma unroll
                for (int c = 0; c < 8; ++c) { const v4u r = vp[c];
                    o[8 * c + 0] += w * bflo(r.x); o[8 * c + 1] += w * bfhi(r.x); o[8 * c + 2] += w * bflo(r.y); o[8 * c + 3] += w * bfhi(r.y);
                    o[8 * c + 4] += w * bflo(r.z); o[8 * c + 5] += w * bfhi(r.z); o[8 * c + 6] += w * bflo(r.w); o[8 * c + 7] += w * bfhi(r.w); }
            }
        }
        if (valid) {
            const int b = bh >> 4, h = bh & 15;
            v4u* op = (v4u*)(O + ((size_t)b * L + t) * D + h * 64);
#pragma unroll
            for (int c = 0; c < 8; ++c) { v4u w; w.x = pk2(o[8 * c + 0], o[8 * c + 1]); w.y = pk2(o[8 * c + 2], o[8 * c + 3]); w.z = pk2(o[8 * c + 4], o[8 * c + 5]); w.w = pk2(o[8 * c + 6], o[8 * c + 7]); op[c] = w; }
        }
    }
}


typedef short bf16x8_t __attribute__((ext_vector_type(8)));
typedef float f32x16 __attribute__((ext_vector_type(16)));
constexpr int SB_LP = 2080;
__device__ __forceinline__ void sb_attn_mfma(const bf16* Q, const bf16* K, const bf16* VT, bf16* O, int gw, int NGW, int lane) {
    constexpr int NQB = (L + 31) / 32;
    const int ql = lane & 31, hi = lane >> 5;
    const int UPW = (128 * (NQB - 1) + NGW - 1) / NGW;
    for (int it = 0; it <= UPW; ++it) {
        int bh, qb;
        if (it < UPW) { const int w2 = gw * UPW + it; if (w2 >= 128 * (NQB - 1)) continue; bh = w2 / (NQB - 1); qb = w2 - bh * (NQB - 1) + 1; }
        else { if (gw >= 128) break; bh = gw; qb = 0; }
        const int tq = 32 * qb + ql; const bool valid = tq < L; const int tqc = valid ? tq : L - 1;
        const bf16* Qb = Q + (size_t)bh * L * 64; const bf16* Kb = K + (size_t)bh * L * 64; const bf16* Vb = VT + (size_t)bh * 65 * 2048;
        bf16x8_t qf[4];
#pragma unroll
        for (int t = 0; t < 4; ++t) qf[t] = *(const bf16x8_t*)(Qb + (size_t)tqc * 64 + 16 * t + 8 * hi);
        f32x16 o0, o1;
#pragma unroll
        for (int r = 0; r < 16; ++r) { o0[r] = 0.f; o1[r] = 0.f; }
        float surv = 1.0f;
        bf16x8_t kn[4]; v2u vn[2][2][2];
#define SB_LOAD(kt_) do { const bf16* kp_ = Kb + (size_t)(32 * (kt_) + ql) * 64 + 8 * hi; \
        _Pragma("unroll") for (int t = 0; t < 4; ++t) kn[t] = *(const bf16x8_t*)(kp_ + 16 * t); \
        _Pragma("unroll") for (int mb = 0; mb < 2; ++mb) { const v4u* vp_ = (const v4u*)(Vb + ((size_t)(kt_) * 2 + mb) * 1024 + lane * 16); const v4u x0 = vp_[0], x1 = vp_[1]; \
            vn[mb][0][0] = (v2u){x0.x, x0.y}; vn[mb][0][1] = (v2u){x0.z, x0.w}; vn[mb][1][0] = (v2u){x1.x, x1.y}; vn[mb][1][1] = (v2u){x1.z, x1.w}; } \
        if (32 * (kt_) + 16 >= L) { vn[0][1][0] = (v2u){0u, 0u}; vn[0][1][1] = (v2u){0u, 0u}; vn[1][1][0] = (v2u){0u, 0u}; vn[1][1][1] = (v2u){0u, 0u}; } } while (0)
        bf16x8_t km[4]; v2u vm[2][2][2];
        SB_LOAD(qb);
#define SB_SHIFT(KD, VD, KS, VS) do { _Pragma("unroll") for (int t = 0; t < 4; ++t) KD[t] = KS[t]; \
        _Pragma("unroll") for (int mb = 0; mb < 2; ++mb) _Pragma("unroll") for (int s = 0; s < 2; ++s) { VD[mb][s][0] = VS[mb][s][0]; VD[mb][s][1] = VS[mb][s][1]; } } while (0)
        SB_SHIFT(km, vm, kn, vn);
        if (qb > 0) SB_LOAD(qb - 1);
        f32x16 Sn;
#pragma unroll
        for (int r = 0; r < 16; ++r) Sn[r] = 0.f;
#pragma unroll
        for (int t = 0; t < 4; ++t) Sn = __builtin_amdgcn_mfma_f32_32x32x16_bf16(km[t], qf[t], Sn, 0, 0, 0);
        for (int kt = qb; kt >= 0; --kt) {
            bf16x8_t kf[4]; v2u vf[2][2][2];
            SB_SHIFT(kf, vf, km, vm);
            SB_SHIFT(km, vm, kn, vn);
            if (kt > 1) SB_LOAD(kt - 2);
            const f32x16 S = Sn;
            if (kt > 0) {
#pragma unroll
                for (int r = 0; r < 16; ++r) Sn[r] = 0.f;
#pragma unroll
                for (int t = 0; t < 4; ++t) Sn = __builtin_amdgcn_mfma_f32_32x32x16_bf16(km[t], qf[t], Sn, 0, 0, 0);
            }
            const bool diag = (kt == qb);
            float om[16], be[16], w[16];
#pragma unroll
            for (int r = 0; r < 16; ++r) {
                const float z = S[r] * 0.125f; const int kl = 8 * (r >> 2) + 4 * hi + (r & 3);
                const bool vis = !diag || kl < ql;
                const float t = __expf(-fmaxf(z, -80.0f));
                const float b = __builtin_amdgcn_rcpf(1.0f + t);
                be[r] = vis ? b : 0.f; om[r] = vis ? t * b : 1.0f;
            }
            float gp = 1.0f;
#pragma unroll
            for (int g = 3; g >= 0; --g) {
                const float T = (om[4 * g] * om[4 * g + 1]) * (om[4 * g + 2] * om[4 * g + 3]);
                const float U = __shfl_xor(T, 32);
                const float a3 = surv * gp * (hi == 0 ? U : 1.0f), a2 = a3 * om[4 * g + 3], a1 = a2 * om[4 * g + 2], a0 = a1 * om[4 * g + 1];
                w[4 * g + 3] = be[4 * g + 3] * a3; w[4 * g + 2] = be[4 * g + 2] * a2; w[4 * g + 1] = be[4 * g + 1] * a1; w[4 * g] = be[4 * g] * a0;
                gp *= T * U;
            }
            surv *= gp;
#pragma unroll
            for (int s = 0; s < 2; ++s) {
                v4u pw; pw.x = pk2(w[8 * s], w[8 * s + 1]); pw.y = pk2(w[8 * s + 2], w[8 * s + 3]); pw.z = pk2(w[8 * s + 4], w[8 * s + 5]); pw.w = pk2(w[8 * s + 6], w[8 * s + 7]);
                const bf16x8_t wb = __builtin_bit_cast(bf16x8_t, pw);
                v4u a0v; a0v.x = vf[0][s][0].x; a0v.y = vf[0][s][0].y; a0v.z = vf[0][s][1].x; a0v.w = vf[0][s][1].y;
                v4u a1v; a1v.x = vf[1][s][0].x; a1v.y = vf[1][s][0].y; a1v.z = vf[1][s][1].x; a1v.w = vf[1][s][1].y;
                o0 = __builtin_amdgcn_mfma_f32_32x32x16_bf16(__builtin_bit_cast(bf16x8_t, a0v), wb, o0, 0, 0, 0);
                o1 = __builtin_amdgcn_mfma_f32_32x32x16_bf16(__builtin_bit_cast(bf16x8_t, a1v), wb, o1, 0, 0, 0);
            }
            if (__ballot(valid && surv >= 1.17549435e-38f) == 0ull) break;
        }
#undef SB_LOAD
#undef SB_SHIFT
        if (valid) {
            const int b = bh >> 4, h = bh & 15;
            bf16* op = O + ((size_t)b * L + tq) * D + h * 64 + 4 * hi;
#pragma unroll
            for (int g = 0; g < 4; ++g) {
                v2u w0; w0.x = pk2(o0[4 * g], o0[4 * g + 1]); w0.y = pk2(o0[4 * g + 2], o0[4 * g + 3]); *(v2u*)(op + 8 * g) = w0;
                v2u w1; w1.x = pk2(o1[4 * g], o1[4 * g + 1]); w1.y = pk2(o1[4 * g + 2], o1[4 * g + 3]); *(v2u*)(op + 32 + 8 * g) = w1;
            }
        }
    }
}

#ifndef GLA_CHUNKED
#define GLA_CHUNKED 1
#endif
__device__ __forceinline__ void gla_decay_phase(const float* GL, const float* Wg, const float* bg, float* A, int tid, int G) {
    const int k = tid; float wg[16];
#pragma unroll
    for (int j = 0; j < 16; ++j) wg[j] = Wg[j * 512 + k];
    const float bk = bg[k];
    for (int row0 = blockIdx.x * 4; row0 < M; row0 += G * 4) {
        f32x4 g[4][4];
#pragma unroll
        for (int u = 0; u < 4; ++u)
#pragma unroll
            for (int q = 0; q < 4; ++q) g[u][q] = *(const f32x4*)(GL + (size_t)(row0 + u) * 16 + 4 * q);
#pragma unroll
        for (int u = 0; u < 4; ++u) {
            float x = bk;
#pragma unroll
            for (int q = 0; q < 4; ++q) x += (g[u][q][0] * wg[4 * q] + g[u][q][1] * wg[4 * q + 1]) + (g[u][q][2] * wg[4 * q + 2] + g[u][q][3] * wg[4 * q + 3]);
            const float ls = fminf(x, 0.f) - __logf(1.0f + __expf(-fabsf(x)));
            A[(size_t)(row0 + u) * 512 + k] = GLA_CHUNKED ? ls * (1.0f / 16.0f) : __expf(ls * (1.0f / 16.0f));
        }
    }
}

__device__ __forceinline__ void gla_scan_phase(const bf16* P, const float* A, float* OG, LAS unsigned char* lds, int tid, int wave, int lane, int G) {
    LAS unsigned char* la = lds; LAS unsigned char* lk = lds + 32768; LAS unsigned char* lq = lds + 49152; LAS unsigned char* lv = lds + 65536; LAS float* lo = (LAS float*)(lds + 69632);
    const int ks = lane >> 2, vi = lane & 3, vcol = 4 * wave + vi;
    for (int unit = blockIdx.x; unit < 256; unit += G) {
        const int b = unit >> 5, h = (unit >> 3) & 3, vq = unit & 7;
        float S[8];
#pragma unroll
        for (int j = 0; j < 8; ++j) S[j] = 0.f;
        v4u ra[4], rk[2], rq[2], rv;
        const int NCH = (L + 63) / 64;
#define GLA_LOAD(c) do { const int n_ = min(64, L - 64 * (c)); const size_t m0_ = (size_t)b * L + 64 * (c); \
        _Pragma("unroll") for (int i = 0; i < 4; ++i) { const int p = tid + 512 * i, r = p >> 5, cc = p & 31; ra[i] = r < n_ ? *(const v4u*)(A + (m0_ + r) * 512 + 128 * h + 4 * cc) : (v4u){0u, 0u, 0u, 0u}; } \
        _Pragma("unroll") for (int i = 0; i < 2; ++i) { const int p = tid + 512 * i, r = p >> 4, cc = p & 15; \
            rk[i] = r < n_ ? *(const v4u*)(P + (m0_ + r) * 3072 + 512 + 128 * h + 8 * cc) : (v4u){0u, 0u, 0u, 0u}; rq[i] = r < n_ ? *(const v4u*)(P + (m0_ + r) * 3072 + 128 * h + 8 * cc) : (v4u){0u, 0u, 0u, 0u}; } \
        { const int r = tid >> 2, cc = tid & 3; rv = (tid < 256 && r < n_) ? *(const v4u*)(P + (m0_ + r) * 3072 + 1024 + 256 * h + 32 * vq + 8 * cc) : (v4u){0u, 0u, 0u, 0u}; } } while (0)
        GLA_LOAD(0);
        for (int c = 0; c < NCH; ++c) {
            const int n = min(64, L - 64 * c);
#pragma unroll
            for (int i = 0; i < 4; ++i) { const int p = tid + 512 * i; *(LAS v4u*)(la + p * 16) = ra[i]; }
#pragma unroll
            for (int i = 0; i < 2; ++i) { const int p = tid + 512 * i; *(LAS v4u*)(lk + p * 16) = rk[i]; *(LAS v4u*)(lq + p * 16) = rq[i]; }
            if (tid < 256) *(LAS v4u*)(lv + tid * 16) = rv;
            __syncthreads();
            if (c + 1 < NCH) GLA_LOAD(c + 1);
            for (int tt0 = 0; tt0 < n; tt0 += 4) {
                float ov[4];
#pragma unroll
                for (int u = 0; u < 4; ++u) {
                    const int tt = tt0 + u;
                    const f32x4 a0 = *(const LAS f32x4*)(la + tt * 512 + ks * 32), a1 = *(const LAS f32x4*)(la + tt * 512 + ks * 32 + 16);
                    const v4u kr = *(const LAS v4u*)(lk + tt * 256 + ks * 16), qr = *(const LAS v4u*)(lq + tt * 256 + ks * 16);
                    const float vv = __builtin_bit_cast(float, (unsigned)(*(const LAS unsigned short*)(lv + tt * 64 + vcol * 2)) << 16);
                    float o, o2;
                    S[0] = S[0] * a0[0] + bflo(kr.x) * vv; o  = bflo(qr.x) * S[0];
                    S[1] = S[1] * a0[1] + bfhi(kr.x) * vv; o2 = bfhi(qr.x) * S[1];
                    S[2] = S[2] * a0[2] + bflo(kr.y) * vv; o  += bflo(qr.y) * S[2];
                    S[3] = S[3] * a0[3] + bfhi(kr.y) * vv; o2 += bfhi(qr.y) * S[3];
                    S[4] = S[4] * a1[0] + bflo(kr.z) * vv; o  += bflo(qr.z) * S[4];
                    S[5] = S[5] * a1[1] + bfhi(kr.z) * vv; o2 += bfhi(qr.z) * S[5];
                    S[6] = S[6] * a1[2] + bflo(kr.w) * vv; o  += bflo(qr.w) * S[6];
                    S[7] = S[7] * a1[3] + bfhi(kr.w) * vv; o2 += bfhi(qr.w) * S[7];
                    ov[u] = o + o2;
                }
#pragma unroll
                for (int u = 0; u < 4; ++u) {
                    const int x = __builtin_bit_cast(int, ov[u]);
                    const float r4 = __builtin_bit_cast(float, __builtin_amdgcn_update_dpp(0, x, 0x124, 0xf, 0xf, false));
                    const float r8 = __builtin_bit_cast(float, __builtin_amdgcn_update_dpp(0, x, 0x128, 0xf, 0xf, false));
                    const float r12 = __builtin_bit_cast(float, __builtin_amdgcn_update_dpp(0, x, 0x12C, 0xf, 0xf, false));
                    ov[u] = (ov[u] + r4) + (r8 + r12);
                }
                if ((lane & 12) == 0) {
#pragma unroll
                    for (int u = 0; u < 4; ++u) lo[((tt0 + u) * 4 + (lane >> 4)) * 32 + vcol] = ov[u] * 0.08838834764831845f;
                }
            }
            __syncthreads();
            const size_t m0 = (size_t)b * L + 64 * c;
#pragma unroll
            for (int i = 0; i < 4; ++i) { const int idx = tid + 512 * i, r = idx >> 5, cc = idx & 31; if (r < n) OG[(m0 + r) * 1024 + 256 * h + 32 * vq + cc] = (lo[(r * 4 + 0) * 32 + cc] + lo[(r * 4 + 1) * 32 + cc]) + (lo[(r * 4 + 2) * 32 + cc] + lo[(r * 4 + 3) * 32 + cc]); }
        }
#undef GLA_LOAD
        __syncthreads();
    }
}


constexpr int GLA_NCH = 33, GLA_UNITS = NB * GLA_NCH * 4;
constexpr size_t WS_GQD = 244 * MiB, WS_GKST = 3 * MiB, WS_GATT = 376 * MiB, WS_GDEC = 385 * MiB, WS_GVT = 343 * MiB;
__device__ __forceinline__ void gla_pre_phase(const bf16* P, const float* GL, const float* Wg, const float* bg, bf16* QDP, bf16* KST, bf16* ATT, bf16* VT2, float* DEC, LAS unsigned char* lds, int tid, int wave, int lane, int G) {
    LAS float* Bm = (LAS float*)lds;
    LAS unsigned short* QDl = (LAS unsigned short*)(lds + 32768);
    LAS unsigned short* KDl = (LAS unsigned short*)(lds + 49152);
    LAS unsigned short* KSl = (LAS unsigned short*)(lds + 65536);
    LAS unsigned short* VTl = (LAS unsigned short*)(lds + 81920);
    LAS float* TOT = (LAS float*)(lds + 114688);
    LAS float* GLs = (LAS float*)(lds + 116736);
    for (int u = blockIdx.x; u < GLA_UNITS; u += G) {
        const int h = u & 3, bn = u >> 2, n = bn % GLA_NCH, b = bn / GLA_NCH;
        const int t0 = 64 * n - 48;
        v4u pq0 = (v4u){0u, 0u, 0u, 0u}, pq1 = pq0, pk0 = pq0, pk1 = pq0;
        { const int t = t0 + (tid >> 3); if (t >= 0) { const bf16* pr = P + ((size_t)b * L + t) * 3072 + 128 * h + 16 * (tid & 7); pq0 = *(const v4u*)pr; pq1 = *(const v4u*)(pr + 8); pk0 = *(const v4u*)(pr + 512); pk1 = *(const v4u*)(pr + 520); } }
#pragma unroll
        for (int i = 0; i < 4; ++i) {
            const int p = tid + 512 * i, r = p >> 5, cc = p & 31, t = t0 + r;
            v4u vv = (v4u){0u, 0u, 0u, 0u};
            if (t >= 0) vv = *(const v4u*)(P + ((size_t)b * L + t) * 3072 + 1024 + 256 * h + 8 * cc);
            LAS unsigned short* vp = VTl + (8 * cc) * 64 + (r ^ (8 * (cc & 7)));
            vp[0] = (unsigned short)(vv.x & 0xffffu); vp[64] = (unsigned short)(vv.x >> 16); vp[128] = (unsigned short)(vv.y & 0xffffu); vp[192] = (unsigned short)(vv.y >> 16);
            vp[256] = (unsigned short)(vv.z & 0xffffu); vp[320] = (unsigned short)(vv.z >> 16); vp[384] = (unsigned short)(vv.w & 0xffffu); vp[448] = (unsigned short)(vv.w >> 16);
        }
        if (tid < 256) { const int r = tid >> 2, cc = tid & 3, t = t0 + r;
            *(LAS f32x4*)(GLs + r * 16 + 4 * cc) = t >= 0 ? *(const f32x4*)(GL + ((size_t)b * L + t) * 16 + 4 * cc) : (f32x4){0.f, 0.f, 0.f, 0.f}; }
        __syncthreads();
        { const int k = tid & 127, seg = tid >> 7; float run = 0.f;
          float wg[16];
#pragma unroll
          for (int j2 = 0; j2 < 16; ++j2) wg[j2] = Wg[j2 * 512 + 128 * h + k];
          const float bk = bg[128 * h + k];
#pragma unroll 4
          for (int i = 0; i < 16; ++i) {
              const int row = 16 * seg + i; const LAS f32x4* gr = (const LAS f32x4*)(GLs + row * 16);
              const f32x4 g0 = gr[0], g1 = gr[1], g2 = gr[2], g3 = gr[3];
              float x = bk + (g0[0] * wg[0] + g0[1] * wg[1]) + (g0[2] * wg[2] + g0[3] * wg[3]) + (g1[0] * wg[4] + g1[1] * wg[5]) + (g1[2] * wg[6] + g1[3] * wg[7])
                           + (g2[0] * wg[8] + g2[1] * wg[9]) + (g2[2] * wg[10] + g2[3] * wg[11]) + (g3[0] * wg[12] + g3[1] * wg[13]) + (g3[2] * wg[14] + g3[3] * wg[15]);
              const float ls = fminf(x, 0.f) - __logf(1.0f + __expf(-fabsf(x)));
              run += (t0 + row >= 0) ? ls * (1.0f / 16.0f) : 0.f; Bm[row * 128 + k] = run;
          }
          TOT[seg * 128 + k] = run; }
        __syncthreads();
        { const int k = tid & 127, seg = tid >> 7; float pre = 0.f;
          for (int s = 0; s < seg; ++s) pre += TOT[s * 128 + k];
          if (seg) {
#pragma unroll
              for (int i = 0; i < 16; ++i) Bm[(16 * seg + i) * 128 + k] += pre; } }
        __syncthreads();
        { const int c = tid >> 3, sg = tid & 7, t = t0 + c;
          const v4u q0 = pq0, q1 = pq1, k0 = pk0, k1 = pk1;
          const unsigned qw[8] = {q0.x, q0.y, q0.z, q0.w, q1.x, q1.y, q1.z, q1.w}, kw[8] = {k0.x, k0.y, k0.z, k0.w, k1.x, k1.y, k1.z, k1.w};
          float qd[16], kd[16];
#pragma unroll
          for (int e = 0; e < 16; ++e) {
              const float bb = Bm[c * 128 + 16 * sg + e], bl = Bm[63 * 128 + 16 * sg + e];
              const float qv = (e & 1) ? bfhi(qw[e >> 1]) : bflo(qw[e >> 1]), kv = (e & 1) ? bfhi(kw[e >> 1]) : bflo(kw[e >> 1]);
              qd[e] = qv * 0.08838834764831845f * __expf(bb); kd[e] = kv * __expf(-bb);
              KSl[(16 * sg + e) * 64 + (c ^ (8 * sg))] = (unsigned short)f2bf(kv * __expf(bl - bb));
          }
          v4u a0, a1, b0, b1;
          a0.x = pk2(qd[0], qd[1]); a0.y = pk2(qd[2], qd[3]); a0.z = pk2(qd[8], qd[9]); a0.w = pk2(qd[10], qd[11]);
          a1.x = pk2(qd[4], qd[5]); a1.y = pk2(qd[6], qd[7]); a1.z = pk2(qd[12], qd[13]); a1.w = pk2(qd[14], qd[15]);
          b0.x = pk2(kd[0], kd[1]); b0.y = pk2(kd[2], kd[3]); b0.z = pk2(kd[8], kd[9]); b0.w = pk2(kd[10], kd[11]);
          b1.x = pk2(kd[4], kd[5]); b1.y = pk2(kd[6], kd[7]); b1.z = pk2(kd[12], kd[13]); b1.w = pk2(kd[14], kd[15]);
          *(LAS v4u*)(QDl + c * 128 + 16 * sg) = a0; *(LAS v4u*)(QDl + c * 128 + 16 * sg + 8) = a1;
          *(LAS v4u*)(KDl + c * 128 + 16 * sg) = b0; *(LAS v4u*)(KDl + c * 128 + 16 * sg + 8) = b1;
          bf16* gq = QDP + (size_t)u * 8192 + c * 128 + 16 * sg; *(v4u*)gq = a0; *(v4u*)(gq + 8) = a1;
        }
        if (tid < 128) DEC[(size_t)u * 128 + tid] = __expf(Bm[63 * 128 + tid]);
        __syncthreads();
        if (wave < 4) {
            const int mb = wave >> 1, nb = wave & 1, ql = lane & 31, hi = lane >> 5;
            f32x16 acc;
#pragma unroll
            for (int r = 0; r < 16; ++r) acc[r] = 0.f;
#pragma unroll
            for (int st = 0; st < 8; ++st) {
                const bf16x8_t a = *(const LAS bf16x8_t*)(QDl + (32 * mb + ql) * 128 + 16 * st + 8 * hi), bq = *(const LAS bf16x8_t*)(KDl + (32 * nb + ql) * 128 + 16 * st + 8 * hi);
                acc = __builtin_amdgcn_mfma_f32_32x32x16_bf16(a, bq, acc, 0, 0, 0);
            }
            bf16* ap = ATT + (size_t)u * 4096 + 32 * nb + ql;
#pragma unroll
            for (int r = 0; r < 16; ++r) { const int c = 32 * mb + 8 * (r >> 2) + 4 * hi + (r & 3), s = 32 * nb + ql; ap[c * 64] = (bf16)f2bf(s <= c ? acc[r] : 0.f); }
        }
#pragma unroll
        for (int i = 0; i < 2; ++i) { const int p = tid + 512 * i, kk = p >> 3, ch = p & 7; *(v4u*)(KST + (size_t)u * 8192 + p * 8) = *(const LAS v4u*)(KSl + kk * 64 + 8 * (ch ^ ((kk >> 4) & 7))); }
#pragma unroll
        for (int i = 0; i < 4; ++i) { const int p = tid + 512 * i, vv2 = p >> 3, ch = p & 7; *(v4u*)(VT2 + (size_t)u * 16384 + p * 8) = *(const LAS v4u*)(VTl + vv2 * 64 + 8 * (ch ^ ((vv2 >> 3) & 7))); }
        __syncthreads();
    }
}

__device__ __forceinline__ bf16x8_t gla_pack(const f32x16& x, int half) {
    v4u p; p.x = pk2(x[8 * half], x[8 * half + 1]); p.y = pk2(x[8 * half + 2], x[8 * half + 3]); p.z = pk2(x[8 * half + 4], x[8 * half + 5]); p.w = pk2(x[8 * half + 6], x[8 * half + 7]);
    return __builtin_bit_cast(bf16x8_t, p);
}
__device__ __forceinline__ void gla_seq_phase(const bf16* QDP, const bf16* KST, const bf16* ATT, const bf16* VT2, const float* DEC, float* OG, LAS unsigned char* lds, int tid, int wave, int lane, int G) {
    volatile LAS unsigned* flags = (volatile LAS unsigned*)(lds + 16384);
    if (tid < 4) flags[tid] = 0u;
    __syncthreads();
    const int unit = blockIdx.x;
    if (wave >= 3 || unit >= 256) return;
    const int ql = lane & 31, hi = lane >> 5;
    const int xcd = unit & 7, idx = unit >> 3, bhx = xcd * 4 + (idx >> 3);
    const int b = bhx >> 2, h = bhx & 3, vs = idx & 7;
    const size_t u0 = (size_t)(b * GLA_NCH) * 4 + h;
    const bf16* vtb = VT2 + u0 * 16384 + (size_t)(32 * vs + ql) * 64 + 8 * hi;
#define GLA_SPIN(cond) do { unsigned sp_ = 0; while ((cond) && ++sp_ < (1u << 22)) __builtin_amdgcn_s_sleep(1); } while (0)
    if (wave == 0) {
        const bf16* ksb = KST + u0 * 8192 + ql * 64 + 8 * hi; const float* decb = DEC + u0 * 128 + 4 * hi;
        f32x16 S0, S1, S2, S3;
#pragma unroll
        for (int r = 0; r < 16; ++r) { S0[r] = 0.f; S1[r] = 0.f; S2[r] = 0.f; S3[r] = 0.f; }
        bf16x8_t vf[4], k0[4], k1[4], k2[4], k3[4]; f32x4 d0[4], d1[4], d2[4], d3[4];
#pragma unroll
        for (int st = 0; st < 4; ++st) { vf[st] = *(const bf16x8_t*)(vtb + 16 * st); k0[st] = *(const bf16x8_t*)(ksb + 16 * st); k1[st] = *(const bf16x8_t*)(ksb + 2048 + 16 * st);
            k2[st] = *(const bf16x8_t*)(ksb + 4096 + 16 * st); k3[st] = *(const bf16x8_t*)(ksb + 6144 + 16 * st);
            d0[st] = *(const f32x4*)(decb + 8 * st); d1[st] = *(const f32x4*)(decb + 32 + 8 * st); d2[st] = *(const f32x4*)(decb + 64 + 8 * st); d3[st] = *(const f32x4*)(decb + 96 + 8 * st); }
        for (int n = 0; n < GLA_NCH; ++n) {
            if (n >= 2) { GLA_SPIN(flags[1] < (unsigned)(n - 1) || flags[2] < (unsigned)(n - 1)); }
            LAS unsigned char* slot = lds + (n & 1) * 8192 + lane * 16;
            *(LAS bf16x8_t*)(slot + 0 * 1024) = gla_pack(S0, 0); *(LAS bf16x8_t*)(slot + 1 * 1024) = gla_pack(S0, 1); *(LAS bf16x8_t*)(slot + 2 * 1024) = gla_pack(S1, 0); *(LAS bf16x8_t*)(slot + 3 * 1024) = gla_pack(S1, 1);
            *(LAS bf16x8_t*)(slot + 4 * 1024) = gla_pack(S2, 0); *(LAS bf16x8_t*)(slot + 5 * 1024) = gla_pack(S2, 1); *(LAS bf16x8_t*)(slot + 6 * 1024) = gla_pack(S3, 0); *(LAS bf16x8_t*)(slot + 7 * 1024) = gla_pack(S3, 1);
            __builtin_amdgcn_fence(__ATOMIC_RELEASE, "workgroup");
            if (lane == 0) flags[0] = (unsigned)(n + 1);
            const int nn = n + 1 < GLA_NCH ? n + 1 : n;
            const bf16* ksn = ksb + (size_t)nn * 4 * 8192; const float* decn = decb + (size_t)nn * 4 * 128; const bf16* vtn = vtb + (size_t)nn * 4 * 16384;
#define GLA_SUPD(SX, KX, DX, kb) do { _Pragma("unroll") for (int g = 0; g < 4; ++g) { SX[4 * g] *= DX[g][0]; SX[4 * g + 1] *= DX[g][1]; SX[4 * g + 2] *= DX[g][2]; SX[4 * g + 3] *= DX[g][3]; } \
                _Pragma("unroll") for (int g = 0; g < 4; ++g) DX[g] = *(const f32x4*)(decn + 32 * (kb) + 8 * g); \
                _Pragma("unroll") for (int st = 0; st < 4; ++st) SX = __builtin_amdgcn_mfma_f32_32x32x16_bf16(KX[st], vf[st], SX, 0, 0, 0); \
                _Pragma("unroll") for (int st = 0; st < 4; ++st) KX[st] = *(const bf16x8_t*)(ksn + (kb) * 2048 + 16 * st); } while (0)
            GLA_SUPD(S0, k0, d0, 0); GLA_SUPD(S1, k1, d1, 1); GLA_SUPD(S2, k2, d2, 2); GLA_SUPD(S3, k3, d3, 3);
#undef GLA_SUPD
#pragma unroll
            for (int st = 0; st < 4; ++st) vf[st] = *(const bf16x8_t*)(vtn + 16 * st);
        }
    } else {
        const int mb = wave - 1;
        const bf16* attb = ATT + u0 * 4096 + (size_t)(32 * mb + ql) * 64 + 8 * hi; const bf16* qdb = QDP + u0 * 8192 + (size_t)(32 * mb + ql) * 128 + 8 * hi;
        bf16x8_t vf[4], af[4], qf[8];
#pragma unroll
        for (int st = 0; st < 4; ++st) { vf[st] = *(const bf16x8_t*)(vtb + 16 * st); af[st] = *(const bf16x8_t*)(attb + 16 * st); }
#pragma unroll
        for (int st = 0; st < 8; ++st) qf[st] = *(const bf16x8_t*)(qdb + 16 * st);
        for (int n = 0; n < GLA_NCH; ++n) {
            const int nn = n + 1 < GLA_NCH ? n + 1 : n;
            f32x16 o;
#pragma unroll
            for (int r = 0; r < 16; ++r) o[r] = 0.f;
#pragma unroll
            for (int st = 0; st < 4; ++st) o = __builtin_amdgcn_mfma_f32_32x32x16_bf16(af[st], vf[st], o, 0, 0, 0);
#pragma unroll
            for (int st = 0; st < 4; ++st) { af[st] = *(const bf16x8_t*)(attb + (size_t)nn * 4 * 4096 + 16 * st); vf[st] = *(const bf16x8_t*)(vtb + (size_t)nn * 4 * 16384 + 16 * st); }
            GLA_SPIN(flags[0] < (unsigned)(n + 1));
            __builtin_amdgcn_fence(__ATOMIC_ACQUIRE, "workgroup");
            const LAS unsigned char* slot = lds + (n & 1) * 8192 + lane * 16;
            bf16x8_t sb[8];
#pragma unroll
            for (int st = 0; st < 8; ++st) sb[st] = *(const LAS bf16x8_t*)(slot + st * 1024);
            asm volatile("s_waitcnt lgkmcnt(0)" ::: "memory");
            if (lane == 0) flags[wave] = (unsigned)(n + 1);
#pragma unroll
            for (int st = 0; st < 8; ++st) o = __builtin_amdgcn_mfma_f32_32x32x16_bf16(qf[st], sb[st], o, 0, 0, 0);
#pragma unroll
            for (int st = 0; st < 8; ++st) qf[st] = *(const bf16x8_t*)(qdb + (size_t)nn * 4 * 8192 + 16 * st);
#pragma unroll
            for (int r = 0; r < 16; ++r) { const int t = 64 * n - 48 + 32 * mb + 8 * (r >> 2) + 4 * hi + (r & 3); if (t >= 0) OG[((size_t)b * L + t) * 1024 + 256 * h + 32 * vs + ql] = o[r]; }
        }
    }
#undef GLA_SPIN
}

__device__ __forceinline__ void gla_gate_phase(const float* OG, const bf16* P, const float* gout, bf16* GA, int gw, int NGW, int lane) {
    for (int row = gw; row < M; row += NGW) {
#pragma unroll
        for (int j = 0; j < 4; ++j) {
            const f32x4 o = *((const f32x4*)(OG + (size_t)row * 1024 + 256 * j) + lane);
            const float ss = wave_sum((o[0] * o[0] + o[1] * o[1]) + (o[2] * o[2] + o[3] * o[3]));
            const float r = __builtin_amdgcn_rsqf(ss * (1.0f / 256.0f) + 1e-6f);
            const f32x4 g = *((const f32x4*)(gout + 256 * j) + lane);
            const v2u rr = *((const v2u*)(P + (size_t)row * 3072 + 2048 + 256 * j) + lane);
            const float r0 = bflo(rr.x), r1 = bfhi(rr.x), r2 = bflo(rr.y), r3 = bfhi(rr.y);
            const float y0 = o[0] * r * g[0] * pg8::silu_f(r0), y1 = o[1] * r * g[1] * pg8::silu_f(r1), y2 = o[2] * r * g[2] * pg8::silu_f(r2), y3 = o[3] * r * g[3] * pg8::silu_f(r3);
            v2u w; w.x = pk2(y0, y1); w.y = pk2(y2, y3);
            *((v2u*)(GA + (size_t)row * 1024 + 256 * j) + lane) = w;
        }
    }
}

template <class Epi> __device__ __forceinline__ void run_gemm(LAS unsigned char* lds, const bf16* A, const bf16* Bt, int N, int K, const Epi& E, int G) {
    pg8::Gemm g{A, Bt, MP, N, K}; pg8::StaticOrder S; S.init(MP, N, G, (int)blockIdx.x, K / 64);
    pg8::gemm_phase<Epi, pg8::StaticOrder, true, true>((PG8_LAS unsigned char*)lds, g, S, E);
}
template <class Epi> __device__ __forceinline__ void run_gemm_split(LAS unsigned char* lds, const bf16* A, const bf16* Bt, int K, int nsplit, const Epi& E, int G) {
    pg8::Gemm g{A, Bt, MP, 1024, K}; pg8::SplitTailOrder S; S.init(G, (int)blockIdx.x, K / 64, nsplit);
    pg8::gemm_phase<Epi, pg8::SplitTailOrder, true, true>((PG8_LAS unsigned char*)lds, g, S, E);
}
template <bool FINAL> __device__ __forceinline__ void tail_finalize(const float* SLAB, int nsplit, float* Hp, bf16* HBp, float* SSp, float* OUT, float wres, int gw, int lane) {
    if (gw >= M - 64 * 256) return;
    const int row = 64 * 256 + gw;
    f32x4 a[4];
#pragma unroll
    for (int j = 0; j < 4; ++j) a[j] = (f32x4){0.f, 0.f, 0.f, 0.f};
    for (int s = 0; s < nsplit; ++s)
#pragma unroll
        for (int j = 0; j < 4; ++j) a[j] += *((const f32x4*)(SLAB + ((size_t)s * 256 + gw) * 1024 + 256 * j) + lane);
    float ss = 0.f;
    const int bb = row / L, tt = row - bb * L;
#pragma unroll
    for (int j = 0; j < 4; ++j) {
        v2u* hbp = (v2u*)(HBp + (size_t)row * D + 256 * j) + lane;
        const v2u hw = *hbp;
        const f32x4 hv = (f32x4){bflo(hw.x), bfhi(hw.x), bflo(hw.y), bfhi(hw.y)};
        const f32x4 v = hv + a[j] * wres;
        if (FINAL) { if (tt >= NMETA) *((f32x4*)(OUT + ((size_t)bb * SEQ + (tt - NMETA)) * D + 256 * j) + lane) = v; }
        else { v2u w; w.x = pk2(v[0], v[1]); w.y = pk2(v[2], v[3]); *hbp = w;
               const float r0 = bflo(w.x), r1 = bfhi(w.x), r2 = bflo(w.y), r3 = bfhi(w.y); ss += (r0 * r0 + r1 * r1) + (r2 * r2 + r3 * r3); }
    }
    if (!FINAL) { ss = wave_sum(ss); if (lane < 16) SSp[(size_t)row * 16 + lane] = lane == 0 ? ss : 0.f; }
}

#ifndef SB_NAIVE
#define SB_ATTN_FN sb_attn_mfma
#define SB_VT_PITCH SB_LP
#else
#define SB_ATTN_FN sb_attn_phase
#define SB_VT_PITCH 0
#endif
#ifndef REP_SB
#define REP_SB 1
#endif
#ifndef REP_GU
#define REP_GU 1
#endif
#ifndef REP_MIX
#define REP_MIX 1
#endif
#ifndef REP_DOWN
#define REP_DOWN 1
#endif
#ifndef REP_OUT
#define REP_OUT 1
#endif
#ifndef REP_PRE
#define REP_PRE 1
#endif
#ifndef REP_CONV
#define REP_CONV 1
#endif
#ifndef REP_GATE
#define REP_GATE 1
#endif
#ifndef REP_SCAN
#define REP_SCAN 1
#endif
#ifndef REP_SYNC
#define REP_SYNC 0
#endif
__global__ void __launch_bounds__(NTHR, 2) fwd_megakernel(Args args) {
    extern __shared__ __attribute__((aligned(16))) unsigned char lds_raw[];
    LAS unsigned char* lds = (LAS unsigned char*)lds_raw;
    cg::grid_group grid = cg::this_grid();
    volatile LAS unsigned* MISC = (volatile LAS unsigned*)(lds + 131072 + 320);
    if (threadIdx.x < 32) MISC[threadIdx.x] = 0u;
    __syncthreads();
    if (blockIdx.x == 0) { unsigned* ctl = (unsigned*)(KWS + WS_CTL); for (int i = threadIdx.x; i < XCD_BAR_WORDS; i += NTHR) ctl[CW_BAR + i] = 0u; if (threadIdx.x < 128) ctl[CW_CNT + threadIdx.x] = 0u; }
    XcdBarrier bar; bar.bar = (unsigned*)(KWS + WS_CTL) + CW_BAR; bar.x = 0; bar.st = MISC + 8;
#ifdef USE_CG_SYNC
#define GRID_BAR() grid.sync()
#else
#define GRID_BAR() xcd_barrier(bar)
#endif
    const int wave = __builtin_amdgcn_readfirstlane(threadIdx.x >> 6);
    const int G = gridDim.x, gw = blockIdx.x * NWAVES + wave, NGW = G * NWAVES, GT = G * NTHR;
#define FRESH_TID() ({ int t_ = threadIdx.x; asm volatile("" : "+v"(t_)); t_; })
#define ws KWS
#define H ((float*)(ws + WS_H))
#define HB ((bf16*)(ws + WS_HB))
#define SS ((float*)(ws + WS_SS))
#define ACT ((bf16*)(ws + WS_ACT))

#define RES_GEMM(FIN, Aptr, Wptr, KK, NS, WR, GI) do { \
        pg8::EpiRes E{H, HB, SS, KOUT, WR, (float*)(ws + WS_SLAB), (unsigned*)(ws + WS_CTL) + CW_CNT + 4 * (GI), lds + 131072 + 1024, FIN, NS}; run_gemm_split(lds, Aptr, Wptr, KK, NS, E, G); } while (0)
    { const int tid = FRESH_TID(); prologue_rows(args, ws, gw, NGW, tid & 63); }
    enum { PH_CONV = 0, PH_GU = 1, PH_DOWN = 2, PH_QKV = 3, PH_ATTN = 4, PH_OUT = 5, PH_IN = 6, PH_PRE = 7, PH_SEQ = 8, PH_GATE = 9 };
#pragma unroll 1
    for (int layer = 0; layer < DEPTH; ++layer) {
        const int j = layer >> 1; const bool sb = (layer & 1) == 0; const int np = sb ? 8 : 10;
#pragma unroll 1
        for (int p = 0; p < np; ++p) {
            const int ab = p >= np - 2;
            const int kind = p == 0 ? PH_CONV : (p == 1 || p == np - 2) ? PH_GU : (p == 2 || p == np - 1) ? PH_DOWN : sb ? p : (p == 7 ? PH_OUT : p + 3);
            const bool fin = (layer == DEPTH - 1 && p == np - 1);
            switch (kind) {
            case PH_CONV: if (layer == 0) { const int tid = FRESH_TID(); conv_phase(args, ws, 0, 5, lds, gw, NGW, wave, tid & 63, blockIdx.x * NTHR + tid, GT); } break;
            case PH_GU: case PH_QKV: case PH_IN: {
                const int ek = kind == PH_GU ? 0 : kind == PH_QKV ? 1 : 2;
                const bf16* Wp = (const bf16*)(ws + (ek == 0 ? (ab ? WS_WGUB : WS_WGUA) : WS_WMIX)); const int NN = ek == 0 ? 2 * FF : ek == 1 ? 3 * D : GLA_INP;
                for (int rep = 0; rep < REP_GU; ++rep) {
                    pg8::EpiAny E{ek, pg8::EpiGU{ACT, SS}, pg8::EpiQKV{(bf16*)(ws + WS_Q), (size_t)(WS_K - WS_Q) / 2, SS, KIN(7) + j * 64, KIN(8) + j * 64, SB_VT_PITCH}, pg8::EpiGLAIn{(bf16*)(ws + WS_GP), (float*)(ws + WS_GGL), SS}};
                    run_gemm(lds, HB, Wp, NN, D, E, G); }
                {
                    const int idle0 = ek == 0 ? 150 : ek == 1 ? 12 : 77;
                    if ((int)blockIdx.x >= idle0) { const int tid = FRESH_TID(); const int b0 = (int)blockIdx.x - idle0, nb = G - idle0;
                        int p0 = -1, l0 = 0, p1 = -1, l1 = 0;
                        if (ek == 0 && !ab && layer == 0) { p0 = 3; l0 = 0; }
                        if (ek == 0 && ab && layer + 1 < DEPTH) { p0 = 3; l0 = layer + 1; }
                        if (ek == 1) { p0 = 1; l0 = layer; }
                        if (ek != 0 && layer + 1 < DEPTH) { p1 = 2; l1 = layer + 1; }
#pragma unroll 1
                        for (int q = 0; q < 2; ++q) { const int pp = q ? p1 : p0, ll = q ? l1 : l0; if (pp >= 0) conv_phase(args, ws, ll, pp, lds, b0 * NWAVES + wave, nb * NWAVES, wave, tid & 63, b0 * NTHR + tid, nb * NTHR); }
                    } }
                } break;
            case PH_DOWN: case PH_OUT: {
                const bool dn = kind == PH_DOWN;
                const bf16* Ap = dn ? ACT : (const bf16*)(ws + (sb ? WS_O : WS_GGA)); const bf16* Wp = (const bf16*)(ws + (dn ? (ab ? WS_WDB : WS_WDA) : WS_WO));
                const int KK = dn ? FF : D, ns = dn ? 11 : 4, gi = dn ? layer * 3 + 2 * ab : layer * 3 + 1; const float wr_ = dn ? 0.5f : 1.0f;
                pg8::EpiRes E{H, HB, SS, KOUT, wr_, (float*)(ws + WS_SLAB), (unsigned*)(ws + WS_CTL) + CW_CNT + 4 * gi, lds + 131072 + 1024, fin ? 1 : 0, ns}; run_gemm_split(lds, Ap, Wp, KK, ns, E, G); } break;
            case PH_ATTN: for (int rep = 0; rep < REP_SB; ++rep) { const int tid = FRESH_TID(); SB_ATTN_FN((const bf16*)(ws + WS_Q), (const bf16*)(ws + WS_K), (const bf16*)(ws + WS_V), (bf16*)(ws + WS_O), gw, NGW, tid & 63); } break;
            case PH_PRE: { const int tid = FRESH_TID(); gla_pre_phase((const bf16*)(ws + WS_GP), (const float*)(ws + WS_GGL), KIN(11) + (size_t)j * 16 * 512, KIN(12) + j * 512, (bf16*)(ws + WS_GQD), (bf16*)(ws + WS_GKST), (bf16*)(ws + WS_GATT), (bf16*)(ws + WS_GVT), (float*)(ws + WS_GDEC), lds, tid, wave, tid & 63, G); } break;
            case PH_SEQ: { const int tid = FRESH_TID(); gla_seq_phase((const bf16*)(ws + WS_GQD), (const bf16*)(ws + WS_GKST), (const bf16*)(ws + WS_GATT), (const bf16*)(ws + WS_GVT), (const float*)(ws + WS_GDEC), (float*)(ws + WS_GOG), lds, tid, wave, tid & 63, G); }
                if (wave >= 3) { const int tid = FRESH_TID(); conv_phase(args, ws, layer, 1, lds, blockIdx.x * 5 + (wave - 3), G * 5, wave, tid & 63, 0, 1); } break;
            default: for (int rep = 0; rep < REP_GATE; ++rep) { const int tid = FRESH_TID(); gla_gate_phase((const float*)(ws + WS_GOG), (const bf16*)(ws + WS_GP), KIN(13) + j * 1024, (bf16*)(ws + WS_GGA), gw, NGW, tid & 63); } break;
            }
            if (fin) break;
            if (kind == PH_CONV && layer > 0) continue;
            if (layer == 0 && p == 0) { grid.sync(); bar = xcd_barrier_post((unsigned*)(KWS + WS_CTL) + CW_BAR, MISC + 8); } else GRID_BAR();
        }
    }
}
#undef ws
#undef H
#undef HB
#undef SS
#undef ACT

extern "C" void kernel_launch(void* const* d_in, const int* in_sizes, int n_in, void* d_out, int out_size, void* d_ws, size_t ws_size, hipStream_t stream) {
    static int grid = 0;
    if (grid == 0) {
        if (n_in != 18 || ws_size < WS_END) { fprintf(stderr, "kernel_launch: expected 18 inputs and >= %zu bytes of workspace (got %d, %zu)\n", (size_t)WS_END, n_in, ws_size); grid = -1; return; }
        int dev = 0, cus = 0, per_cu = 0;
        hipGetDevice(&dev); hipDeviceGetAttribute(&cus, hipDeviceAttributeMultiprocessorCount, dev);
        if (hipFuncSetAttribute((const void*)fwd_megakernel, hipFuncAttributeMaxDynamicSharedMemorySize, LDS_BYTES) != hipSuccess) { fprintf(stderr, "kernel_launch: hipFuncSetAttribute failed\n"); grid = -1; return; }
        if (hipOccupancyMaxActiveBlocksPerMultiprocessor(&per_cu, (const void*)fwd_megakernel, NTHR, LDS_BYTES) != hipSuccess || per_cu < 1) { fprintf(stderr, "kernel_launch: occupancy query failed (%d)\n", per_cu); per_cu = 1; }
        (void)hipGetLastError();
        if (cus != 256) { fprintf(stderr, "kernel_launch: built for a 256-CU device (got %d)\n", cus); grid = -1; return; }
        grid = cus * 1;
    }
    if (grid < 0) return;
    Args a{};
    for (int i = 0; i < 18; ++i) a.in[i] = (const float*)d_in[i];
    a.out = (float*)d_out; a.ws = (unsigned char*)d_ws;
    void* kargs[] = {&a};
    hipError_t e = hipLaunchCooperativeKernel((const void*)fwd_megakernel, dim3(grid), dim3(NTHR), kargs, LDS_BYTES, stream);
    if (e != hipSuccess) fprintf(stderr, "kernel_launch: cooperative launch failed: %s (grid %d)\n", hipGetErrorString(e), grid);
}
```
